# Optimizing an MI355X kernel written in HIP

```python
import math
import jax, jax.numpy as jnp
from jax import lax
import numpy as np

D_MODEL = 1024
BATCH = 4
SEQ = 8192
DEPTH = 1

N_META = 16
D_ATTN = D_MODEL // 2
D_CONV = D_MODEL // 2
D_MIX = D_ATTN + D_CONV
HEAD_DIM = 64
N_DIFF_HEADS = D_ATTN // (2 * HEAD_DIM)
CONV_WIDTH = 31
D_FF = 2816
ROPE_THETA = 10000.0
Q_BLOCK = 128
NORM_EPS = 1e-5
D_IN_PROJ = 3 * D_ATTN + 2 * D_CONV

kernel_name = "hymba_diffattn_conformer_macaron"


def rmsnorm(x, g):
    xf = x.astype(jnp.float32)
    y = xf * lax.rsqrt(jnp.mean(xf * xf, axis=-1, keepdims=True) + NORM_EPS)
    return (y * g.astype(jnp.float32)).astype(x.dtype)


def swiglu_ffn(x, w_gate, w_up, w_down):
    return (jax.nn.silu(x @ w_gate) * (x @ w_up)) @ w_down


def rope_tables(length):
    pos = jnp.arange(length, dtype=jnp.float32)
    inv_freq = ROPE_THETA ** (-jnp.arange(0, HEAD_DIM, 2, dtype=jnp.float32) / HEAD_DIM)
    ang = pos[:, None] * inv_freq[None, :]
    return jnp.cos(ang), jnp.sin(ang)


def apply_rope(x, cos, sin):
    half = HEAD_DIM // 2
    x1, x2 = x[..., :half], x[..., half:]
    return jnp.concatenate([x1 * cos - x2 * sin, x2 * cos + x1 * sin], axis=-1)


def diff_attention(q, k, v, lam, subln_w, lambda_init):
    B, L, _ = q.shape
    H = N_DIFF_HEADS
    n_blk = -(-L // Q_BLOCK)
    Lp = n_blk * Q_BLOCK
    pad = ((0, 0), (0, Lp - L), (0, 0))
    q = jnp.pad(q, pad).reshape(B, Lp, 2 * H, HEAD_DIM).transpose(0, 2, 1, 3).astype(jnp.float32)
    k = jnp.pad(k, pad).reshape(B, Lp, 2 * H, HEAD_DIM).transpose(0, 2, 1, 3).astype(jnp.float32)
    v = jnp.pad(v, pad).reshape(B, Lp, H, 2 * HEAD_DIM).transpose(0, 2, 1, 3).astype(jnp.float32)
    cos, sin = rope_tables(Lp)
    q = apply_rope(q, cos, sin) * (HEAD_DIM ** -0.5)
    k = apply_rope(k, cos, sin)
    kpos = jnp.arange(Lp)

    def block(i):
        start = i * Q_BLOCK
        qb = lax.dynamic_slice_in_dim(q, start, Q_BLOCK, axis=2)
        s = jnp.einsum('bhqd,bhkd->bhqk', qb, k)
        qpos = start + jnp.arange(Q_BLOCK)
        s = jnp.where(kpos[None, :] <= qpos[:, None], s, -jnp.inf)
        p = jax.nn.softmax(s, axis=-1).reshape(B, H, 2, Q_BLOCK, Lp)
        p = p[:, :, 0] - lam * p[:, :, 1]
        return jnp.einsum('bhqk,bhkv->bhqv', p, v)

    o = lax.map(block, jnp.arange(n_blk))
    o = o.transpose(1, 0, 3, 2, 4).reshape(B, Lp, H, 2 * HEAD_DIM)[:, :L]
    o = rmsnorm(o, subln_w) * (1.0 - lambda_init)
    return o.reshape(B, L, D_ATTN)


def conformer_conv(u, conv_w, conv_b, ln_g, ln_b):
    a, g = jnp.split(u, 2, axis=-1)
    z = a * jax.nn.sigmoid(g)
    z = lax.conv_general_dilated(
        z, conv_w[:, None, :].astype(z.dtype), window_strides=(1,),
        padding=[(CONV_WIDTH - 1, 0)],
        dimension_numbers=('NWC', 'WIO', 'NWC'),
        feature_group_count=D_CONV) + conv_b
    zf = z.astype(jnp.float32)
    mu = jnp.mean(zf, axis=-1, keepdims=True)
    var = jnp.mean(jnp.square(zf - mu), axis=-1, keepdims=True)
    zf = (zf - mu) * lax.rsqrt(var + NORM_EPS) * ln_g.astype(jnp.float32) + ln_b.astype(jnp.float32)
    return jax.nn.silu(zf).astype(u.dtype)


def setup_inputs(seed: int = 0) -> dict:
    key = jax.random.key(seed)
    ks = jax.random.split(key, 24)
    f32 = jnp.float32

    def nrm(k, shape, scale):
        return jax.random.normal(k, shape, f32) * scale

    def gain(k, shape):
        return 1.0 + 0.02 * jax.random.normal(k, shape, f32)

    return {
        "x": jax.random.normal(ks[0], (BATCH, SEQ, D_MODEL), f32),
        "meta_tokens": nrm(ks[1], (N_META, D_MODEL), 1.0),
        "ffn1_norm": gain(ks[2], (DEPTH, D_MODEL)),
        "ffn1_w_gate": nrm(ks[3], (DEPTH, D_MODEL, D_FF), D_MODEL ** -0.5),
        "ffn1_w_up": nrm(ks[4], (DEPTH, D_MODEL, D_FF), D_MODEL ** -0.5),
        "ffn1_w_down": nrm(ks[5], (DEPTH, D_FF, D_MODEL), D_FF ** -0.5),
        "mix_norm": gain(ks[6], (DEPTH, D_MODEL)),
        "w_in": nrm(ks[7], (DEPTH, D_MODEL, D_IN_PROJ), D_MODEL ** -0.5),
        "lambda_q1": nrm(ks[8], (DEPTH, HEAD_DIM), 0.1),
        "lambda_k1": nrm(ks[9], (DEPTH, HEAD_DIM), 0.1),
        "lambda_q2": nrm(ks[10], (DEPTH, HEAD_DIM), 0.1),
        "lambda_k2": nrm(ks[11], (DEPTH, HEAD_DIM), 0.1),
        "subln_w": gain(ks[12], (DEPTH, 2 * HEAD_DIM)),
        "conv_w": nrm(ks[13], (DEPTH, CONV_WIDTH, D_CONV), CONV_WIDTH ** -0.5),
        "conv_b": nrm(ks[14], (DEPTH, D_CONV), 0.02),
        "conv_ln_g": gain(ks[15], (DEPTH, D_CONV)),
        "conv_ln_b": nrm(ks[16], (DEPTH, D_CONV), 0.02),
        "w_out": nrm(ks[17], (DEPTH, D_MIX, D_MODEL), D_MIX ** -0.5),
        "ffn2_norm": gain(ks[18], (DEPTH, D_MODEL)),
        "ffn2_w_gate": nrm(ks[19], (DEPTH, D_MODEL, D_FF), D_MODEL ** -0.5),
        "ffn2_w_up": nrm(ks[20], (DEPTH, D_MODEL, D_FF), D_MODEL ** -0.5),
        "ffn2_w_down": nrm(ks[21], (DEPTH, D_FF, D_MODEL), D_FF ** -0.5),
        "final_norm": gain(ks[22], (D_MODEL,)),
    }


def reference(x, meta_tokens, ffn1_norm, ffn1_w_gate, ffn1_w_up, ffn1_w_down,
              mix_norm, w_in, lambda_q1, lambda_k1, lambda_q2, lambda_k2, subln_w,
              conv_w, conv_b, conv_ln_g, conv_ln_b, w_out,
              ffn2_norm, ffn2_w_gate, ffn2_w_up, ffn2_w_down, final_norm):
    B = x.shape[0]
    meta = jnp.broadcast_to(meta_tokens.astype(x.dtype)[None], (B, N_META, D_MODEL))
    h_res = jnp.concatenate([meta, x], axis=1)

    for l in range(DEPTH):
        h = rmsnorm(h_res, ffn1_norm[l])
        h_res = h_res + 0.5 * swiglu_ffn(h, ffn1_w_gate[l], ffn1_w_up[l], ffn1_w_down[l])

        h = rmsnorm(h_res, mix_norm[l])
        proj = h @ w_in[l]
        q, k, v, u = jnp.split(proj, [D_ATTN, 2 * D_ATTN, 3 * D_ATTN], axis=-1)
        lambda_init = 0.8 - 0.6 * math.exp(-0.3 * l)
        lam = (jnp.exp(jnp.sum(lambda_q1[l].astype(jnp.float32) * lambda_k1[l].astype(jnp.float32)))
               - jnp.exp(jnp.sum(lambda_q2[l].astype(jnp.float32) * lambda_k2[l].astype(jnp.float32)))
               + lambda_init)
        a = diff_attention(q, k, v, lam, subln_w[l], lambda_init).astype(h_res.dtype)
        c = conformer_conv(u, conv_w[l], conv_b[l], conv_ln_g[l], conv_ln_b[l])
        h_res = h_res + jnp.concatenate([a, c], axis=-1) @ w_out[l]

        h = rmsnorm(h_res, ffn2_norm[l])
        h_res = h_res + 0.5 * swiglu_ffn(h, ffn2_w_gate[l], ffn2_w_up[l], ffn2_w_down[l])

    y = rmsnorm(h_res, final_norm)
    return y[:, N_META:]
```

```cpp
#include <hip/hip_runtime.h>
#include <stdint.h>
#include <math.h>

typedef unsigned short bf16_t;
__device__ __forceinline__ float bf2f(bf16_t v) { return __uint_as_float(((unsigned)v) << 16); }
__device__ __forceinline__ bf16_t f2bf(float f) { unsigned u = __float_as_uint(f); return (bf16_t)((u + 0x7fffu + ((u >> 16) & 1u)) >> 16); }

constexpr int NB = 4, S = 8192, D = 1024, NMETA = 16, LSEQ = S + NMETA;
constexpr int M = NB * S;
constexpr int MP = M + 256;
constexpr int RALL = M + NMETA;
constexpr int DFF = 2816, DIN = 2560, DA = 512, DC = 512, HD = 64, NH = 4, CW = 31;
constexpr float EPS = 1e-5f;
constexpr float C2 = 0.125f * 1.4426950408889634f;
constexpr float LAMBDA_INIT = 0.2f;

constexpr size_t MiB = 1u << 20;
constexpr size_t WS_CTL = 0;
constexpr size_t WS_ROPE = 1 * MiB;
constexpr size_t WS_SS = 4 * MiB;
constexpr size_t WS_W = 6 * MiB;
constexpr size_t WS_XR = 48 * MiB;
constexpr size_t WS_XB = 178 * MiB;
constexpr size_t WS_BIG = 244 * MiB;
constexpr size_t SZ_QKVZ = (size_t)MP * 512 * 2;
constexpr size_t WS_Q = WS_BIG, WS_K = WS_Q + SZ_QKVZ, WS_V = WS_K + SZ_QKVZ, WS_Z = WS_V + SZ_QKVZ, WS_AC = WS_Z + SZ_QKVZ;
constexpr size_t WS_END = WS_AC + (size_t)MP * 1024 * 2;
static_assert(WS_BIG + (size_t)MP * DFF * 2 <= 512 * MiB && WS_END <= 512 * MiB, "ws map");

__device__ __forceinline__ int row_pos(int m) { return m < M ? (NMETA + (m & (S - 1))) : (m - M); }
__device__ __forceinline__ float wave_sum(float v) {
#pragma unroll
    for (int o = 1; o < 64; o <<= 1) v += __shfl_xor(v, o);
    return v;
}

namespace nv {
__global__ void __launch_bounds__(256) k_prep_rows(const float* __restrict__ x, const float* __restrict__ meta, bf16_t* XB, float* XR, float* ss1) {
    const int row = blockIdx.x * 4 + (threadIdx.x >> 6), lane = threadIdx.x & 63;
    if (row >= RALL) return;
    const float* src = row < M ? x + (size_t)row * D : meta + (size_t)(row - M) * D;
    float s = 0.f;
    for (int j = 0; j < 4; ++j) {
        const int c = j * 256 + lane * 4;
        const float4 v = *(const float4*)(src + c);
        s += v.x * v.x + v.y * v.y + v.z * v.z + v.w * v.w;
        bf16_t* o = XB + (size_t)row * D + c;
        o[0] = f2bf(v.x); o[1] = f2bf(v.y); o[2] = f2bf(v.z); o[3] = f2bf(v.w);
        if (row >= M) *(float4*)(XR + (size_t)row * D + c) = v;
    }
    s = wave_sum(s);
    if (lane == 0) ss1[row] = s;
}
__device__ __forceinline__ void sincos_d(double a, double& sn, double& cs) {
    const double TWO_OVER_PI = 0.63661977236758134308, PIO2_HI = 1.57079632679489655800e+00, PIO2_LO = 6.12323399573676603587e-17;
    const double kq = rint(a * TWO_OVER_PI);
    double y = fma(-kq, PIO2_HI, a); y = fma(-kq, PIO2_LO, y);
    const double y2 = y * y;
    double sp = -1.0 / 1307674368000.0;
    sp = fma(sp, y2, 1.0 / 6227020800.0);
    sp = fma(sp, y2, -1.0 / 39916800.0);
    sp = fma(sp, y2, 1.0 / 362880.0);
    sp = fma(sp, y2, -1.0 / 5040.0);
    sp = fma(sp, y2, 1.0 / 120.0);
    sp = fma(sp, y2, -1.0 / 6.0);
    const double sy = fma(sp * y2, y, y);
    double cp = 1.0 / 20922789888000.0;
    cp = fma(cp, y2, -1.0 / 87178291200.0);
    cp = fma(cp, y2, 1.0 / 479001600.0);
    cp = fma(cp, y2, -1.0 / 3628800.0);
    cp = fma(cp, y2, 1.0 / 40320.0);
    cp = fma(cp, y2, -1.0 / 720.0);
    cp = fma(cp, y2, 1.0 / 24.0);
    cp = fma(cp, y2, -0.5);
    const double cy = fma(cp, y2, 1.0);
    const long long q = (long long)kq & 3;
    sn = (q == 0) ? sy : (q == 1) ? cy : (q == 2) ? -sy : -cy;
    cs = (q == 0) ? cy : (q == 1) ? -sy : (q == 2) ? -cy : sy;
}
__global__ void __launch_bounds__(256) k_prep_misc(float2* rope, float* lamp, const float* q1, const float* k1, const float* q2, const float* k2) {
    const int idx = blockIdx.x * 256 + threadIdx.x;
    if (idx < LSEQ * 32) {
        const int pos = idx >> 5, i = idx & 31;
        const double inv = exp2(-(double)i * (13.287712379549449 / 32.0));
        double sn, cs; sincos_d((double)pos * inv, sn, cs);
        rope[idx] = make_float2((float)cs, (float)sn);
    }
    if (idx == 0) {
        float a = 0.f, b = 0.f;
        for (int i = 0; i < HD; ++i) { a += q1[i] * k1[i]; b += q2[i] * k2[i]; }
        lamp[0] = expf(a) - expf(b) + LAMBDA_INIT;
    }
}
__global__ void __launch_bounds__(256) k_rowss(const float* __restrict__ X, float* ss, int rows) {
    const int row = blockIdx.x * 4 + (threadIdx.x >> 6), lane = threadIdx.x & 63;
    if (row >= rows) return;
    float s = 0.f;
    for (int j = 0; j < 4; ++j) { const float4 v = *(const float4*)(X + (size_t)row * D + j * 256 + lane * 4); s += v.x * v.x + v.y * v.y + v.z * v.z + v.w * v.w; }
    s = wave_sum(s);
    if (lane == 0) ss[row] = s;
}
__global__ void __launch_bounds__(256) k_final(float* out, const float* __restrict__ ss, const float* __restrict__ g) {
    const int row = blockIdx.x * 4 + (threadIdx.x >> 6), lane = threadIdx.x & 63;
    if (row >= M) return;
    const float rs = rsqrtf(ss[row] * (1.f / D) + EPS);
    for (int j = 0; j < 4; ++j) {
        const int c = j * 256 + lane * 4;
        float4 v = *(float4*)(out + (size_t)row * D + c); const float4 gv = *(const float4*)(g + c);
        v.x *= rs * gv.x; v.y *= rs * gv.y; v.z *= rs * gv.z; v.w *= rs * gv.w;
        *(float4*)(out + (size_t)row * D + c) = v;
    }
}

constexpr int TM = 64, TN = 64, TK = 16;
constexpr int SM_CORE = TK * (TM + 4) + 2 * TK * TN;
template <bool TWO>
__device__ __forceinline__ void core(const bf16_t* __restrict__ A, int lda, int rows, int K, const float* __restrict__ W0, const float* __restrict__ W1, int ldw, int na, int nb,
                                     const float* __restrict__ gain, int m0, float (&acc0)[4][4], float (&acc1)[4][4], float* sm) {
    float (*As)[TM + 4] = (float (*)[TM + 4])sm;
    float (*B0)[TN] = (float (*)[TN])(sm + TK * (TM + 4));
    float (*B1)[TN] = (float (*)[TN])(sm + TK * (TM + 4) + TK * TN);
    const int tid = threadIdx.x, tx = tid & 15, ty = tid >> 4;
#pragma unroll
    for (int i = 0; i < 4; ++i)
#pragma unroll
        for (int j = 0; j < 4; ++j) { acc0[i][j] = 0.f; acc1[i][j] = 0.f; }
    for (int k0 = 0; k0 < K; k0 += TK) {
        {
            const int r = tid >> 2, kq = (tid & 3) * 4, m = m0 + r;
            float a0 = 0.f, a1 = 0.f, a2 = 0.f, a3 = 0.f;
            if (m < rows) { const bf16_t* ap = A + (size_t)m * lda + k0 + kq; a0 = bf2f(ap[0]); a1 = bf2f(ap[1]); a2 = bf2f(ap[2]); a3 = bf2f(ap[3]); }
            As[kq + 0][r] = a0; As[kq + 1][r] = a1; As[kq + 2][r] = a2; As[kq + 3][r] = a3;
        }
        {
            const int kk = tid >> 4, nq = (tid & 15) * 4; const float gk = gain ? gain[k0 + kk] : 1.f;
            const float4 w = *(const float4*)(W0 + (size_t)(k0 + kk) * ldw + na + nq);
            B0[kk][nq + 0] = w.x * gk; B0[kk][nq + 1] = w.y * gk; B0[kk][nq + 2] = w.z * gk; B0[kk][nq + 3] = w.w * gk;
            if (TWO) {
                const float4 w1 = *(const float4*)(W1 + (size_t)(k0 + kk) * ldw + nb + nq);
                B1[kk][nq + 0] = w1.x * gk; B1[kk][nq + 1] = w1.y * gk; B1[kk][nq + 2] = w1.z * gk; B1[kk][nq + 3] = w1.w * gk;
            }
        }
        __syncthreads();
#pragma unroll
        for (int kk = 0; kk < TK; ++kk) {
            float a[4], b[4], c[4];
#pragma unroll
            for (int i = 0; i < 4; ++i) a[i] = As[kk][ty * 4 + i];
#pragma unroll
            for (int j = 0; j < 4; ++j) { b[j] = B0[kk][tx * 4 + j]; c[j] = TWO ? B1[kk][tx * 4 + j] : 0.f; }
#pragma unroll
            for (int i = 0; i < 4; ++i)
#pragma unroll
                for (int j = 0; j < 4; ++j) { acc0[i][j] = fmaf(a[i], b[j], acc0[i][j]); if (TWO) acc1[i][j] = fmaf(a[i], c[j], acc1[i][j]); }
        }
        __syncthreads();
    }
}
__device__ __forceinline__ float silu_f(float v) { return v / (1.f + __expf(-v)); }
__device__ __forceinline__ float sigm_f(float v) { return 1.f / (1.f + __expf(-v)); }

__global__ void __launch_bounds__(256) k_gemm_gu(const bf16_t* XB, const float* Wg, const float* Wu, const float* gain, const float* ss, bf16_t* ACT, int rows) {
    __shared__ float sm[SM_CORE];
    float a0[4][4], a1[4][4];
    const int m0 = blockIdx.y * TM, n0 = blockIdx.x * TN;
    core<true>(XB, D, rows, D, Wg, Wu, DFF, n0, n0, gain, m0, a0, a1, sm);
    const int tx = threadIdx.x & 15, ty = threadIdx.x >> 4;
#pragma unroll
    for (int i = 0; i < 4; ++i) {
        const int m = m0 + ty * 4 + i; if (m >= rows) continue;
        const float rs = rsqrtf(ss[m] * (1.f / D) + EPS);
#pragma unroll
        for (int j = 0; j < 4; ++j) ACT[(size_t)m * DFF + n0 + tx * 4 + j] = f2bf(silu_f(a0[i][j] * rs) * (a1[i][j] * rs));
    }
}
__global__ void __launch_bounds__(256) k_gemm_res(const bf16_t* A, int K, const float* W, const float* resid, const float* resid_meta, float alpha, float* outf, bf16_t* outb, int rows) {
    __shared__ float sm[SM_CORE];
    float a0[4][4], a1[4][4];
    const int m0 = blockIdx.y * TM, n0 = blockIdx.x * TN;
    core<false>(A, K, rows, K, W, nullptr, D, n0, 0, nullptr, m0, a0, a1, sm);
    const int tx = threadIdx.x & 15, ty = threadIdx.x >> 4;
#pragma unroll
    for (int i = 0; i < 4; ++i) {
        const int m = m0 + ty * 4 + i; if (m >= rows) continue;
        const float* rp = m < M ? resid + (size_t)m * D : resid_meta + (size_t)(m - M) * D;
#pragma unroll
        for (int j = 0; j < 4; ++j) {
            const int n = n0 + tx * 4 + j; const float v = rp[n] + alpha * a0[i][j];
            outf[(size_t)m * D + n] = v; if (outb) outb[(size_t)m * D + n] = f2bf(v);
        }
    }
}
__global__ void __launch_bounds__(256) k_gemm_in(const bf16_t* XB, const float* Win, const float* gain, const float* ss, const float2* rope, bf16_t* Q, bf16_t* Kb, bf16_t* Vb, bf16_t* Z, int rows) {
    __shared__ float sm[SM_CORE];
    __shared__ float T[TM][TN + 1];
    float a0[4][4], a1[4][4];
    const int m0 = blockIdx.y * TM, lt = blockIdx.x;
    const int tx = threadIdx.x & 15, ty = threadIdx.x >> 4;
    if (lt < 24) core<false>(XB, D, rows, D, Win, nullptr, DIN, lt * 64, 0, gain, m0, a0, a1, sm);
    else core<true>(XB, D, rows, D, Win, Win, DIN, 1536 + (lt - 24) * 64, 2048 + (lt - 24) * 64, gain, m0, a0, a1, sm);
#pragma unroll
    for (int i = 0; i < 4; ++i) {
        const int m = m0 + ty * 4 + i; const float rs = m < rows ? rsqrtf(ss[m] * (1.f / D) + EPS) : 0.f;
#pragma unroll
        for (int j = 0; j < 4; ++j) { a0[i][j] *= rs; a1[i][j] *= rs; }
    }
    if (lt < 16) {
#pragma unroll
        for (int i = 0; i < 4; ++i)
#pragma unroll
            for (int j = 0; j < 4; ++j) T[ty * 4 + i][tx * 4 + j] = a0[i][j];
        __syncthreads();
        const int hs = lt & 7; bf16_t* O = lt < 8 ? Q : Kb; const float sc = lt < 8 ? C2 : 1.f;
        for (int e = threadIdx.x; e < 64 * 32; e += 256) {
            const int r = e >> 5, c = e & 31, m = m0 + r; if (m >= rows) continue;
            const float2 cs = rope[row_pos(m) * 32 + c]; const float x1 = T[r][c], x2 = T[r][c + 32];
            O[(size_t)m * 512 + hs * 64 + c] = f2bf((x1 * cs.x - x2 * cs.y) * sc);
            O[(size_t)m * 512 + hs * 64 + 32 + c] = f2bf((x2 * cs.x + x1 * cs.y) * sc);
        }
    } else {
#pragma unroll
        for (int i = 0; i < 4; ++i) {
            const int m = m0 + ty * 4 + i; if (m >= rows) continue;
#pragma unroll
            for (int j = 0; j < 4; ++j) {
                const int c = (lt & 7) * 64 + tx * 4 + j;
                if (lt < 24) Vb[(size_t)m * 512 + c] = f2bf(a0[i][j]); else Z[(size_t)m * 512 + c] = f2bf(a0[i][j] * sigm_f(a1[i][j]));
            }
        }
    }
}

__global__ void __launch_bounds__(256) k_attn(const bf16_t* __restrict__ Q, const bf16_t* __restrict__ Kb, const bf16_t* __restrict__ Vb, const float* __restrict__ subw, const float* __restrict__ lamp, bf16_t* AC) {
    __shared__ float Ks[64][64];
    __shared__ bf16_t Vs[64][128];
    __shared__ float Ps[64][65];
    const int qt = blockIdx.x, h = blockIdx.y, b = blockIdx.z;
    const int tid = threadIdx.x, r = tid >> 2, j = tid & 3;
    const int t = qt * 64 + r; const size_t mq = (size_t)b * S + t;
    const float lam = lamp[0];
    float o1[32];
#pragma unroll
    for (int c = 0; c < 32; ++c) o1[c] = 0.f;
    for (int sh = 0; sh < 2; ++sh) {
        const int s = 2 * h + sh;
        float q[64];
#pragma unroll
        for (int d = 0; d < 64; ++d) q[d] = bf2f(Q[mq * 512 + s * 64 + d]);
        float m_run = -INFINITY, l_run = 0.f; float o[32];
#pragma unroll
        for (int c = 0; c < 32; ++c) o[c] = 0.f;
        const int ntile = qt + 2;
        for (int kt = 0; kt < ntile; ++kt) {
            __syncthreads();
            for (int e = tid; e < 64 * 64; e += 256) {
                const int key = e >> 6, d = e & 63; const bool valid = kt == 0 ? key < NMETA : true;
                const size_t row = kt == 0 ? (size_t)(M + (key & 15)) : (size_t)b * S + (kt - 1) * 64 + key;
                Ks[key][d] = valid ? bf2f(Kb[row * 512 + s * 64 + d]) : 0.f;
            }
            for (int e = tid; e < 64 * 128; e += 256) {
                const int key = e >> 7, c = e & 127; const bool valid = kt == 0 ? key < NMETA : true;
                const size_t row = kt == 0 ? (size_t)(M + (key & 15)) : (size_t)b * S + (kt - 1) * 64 + key;
                Vs[key][c] = valid ? Vb[row * 512 + h * 128 + c] : (bf16_t)0;
            }
            __syncthreads();
            float sc[16]; float tmax = -INFINITY;
#pragma unroll
            for (int kk = 0; kk < 16; ++kk) {
                const int key = j * 16 + kk; float a = 0.f;
#pragma unroll
                for (int d = 0; d < 64; ++d) a = fmaf(q[d], Ks[key][d], a);
                const bool ok = kt == 0 ? key < NMETA : ((kt - 1) * 64 + key <= t);
                sc[kk] = ok ? a : -INFINITY; tmax = fmaxf(tmax, sc[kk]);
            }
            tmax = fmaxf(tmax, __shfl_xor(tmax, 1)); tmax = fmaxf(tmax, __shfl_xor(tmax, 2));
            const float m_new = fmaxf(m_run, tmax);
            const float alpha = exp2f(m_run - m_new);
            float psum = 0.f;
#pragma unroll
            for (int kk = 0; kk < 16; ++kk) { const float pv = exp2f(sc[kk] - m_new); psum += pv; Ps[r][j * 16 + kk] = pv; }
            psum += __shfl_xor(psum, 1); psum += __shfl_xor(psum, 2);
            l_run = l_run * alpha + psum; m_run = m_new;
            __syncthreads();
#pragma unroll
            for (int c = 0; c < 32; ++c) o[c] *= alpha;
            for (int key = 0; key < 64; ++key) {
                const float pv = Ps[r][key];
#pragma unroll
                for (int c = 0; c < 32; ++c) o[c] = fmaf(pv, bf2f(Vs[key][j * 32 + c]), o[c]);
            }
        }
        const float il = 1.f / l_run;
        if (sh == 0) {
#pragma unroll
            for (int c = 0; c < 32; ++c) o1[c] = o[c] * il;
        } else {
            float ssq = 0.f;
#pragma unroll
            for (int c = 0; c < 32; ++c) { o1[c] = o1[c] - lam * (o[c] * il); ssq += o1[c] * o1[c]; }
            ssq += __shfl_xor(ssq, 1); ssq += __shfl_xor(ssq, 2);
            const float rn = rsqrtf(ssq * (1.f / 128.f) + EPS) * (1.f - LAMBDA_INIT);
#pragma unroll
            for (int c = 0; c < 32; ++c) AC[mq * 1024 + h * 128 + j * 32 + c] = f2bf(o1[c] * rn * subw[j * 32 + c]);
        }
    }
}
__global__ void __launch_bounds__(256) k_conv(const bf16_t* __restrict__ Z, const float* __restrict__ cw, const float* __restrict__ cb, const float* __restrict__ lg, const float* __restrict__ lb, bf16_t* AC) {
    __shared__ float red[8];
    const int m = blockIdx.x, b = m / S, t = m % S, pos = NMETA + t, tid = threadIdx.x;
    float y[2];
#pragma unroll
    for (int u = 0; u < 2; ++u) {
        const int c = tid + u * 256; float a = cb[c];
        for (int j = 0; j < CW; ++j) {
            const int p = pos - (CW - 1) + j; if (p < 0) continue;
            const size_t row = p < NMETA ? (size_t)(M + p) : (size_t)b * S + (p - NMETA);
            a = fmaf(cw[j * DC + c], bf2f(Z[row * 512 + c]), a);
        }
        y[u] = a;
    }
    float s = wave_sum(y[0] + y[1]);
    if ((tid & 63) == 0) red[tid >> 6] = s;
    __syncthreads();
    const float mu = (red[0] + red[1] + red[2] + red[3]) * (1.f / DC);
    const float d0 = y[0] - mu, d1 = y[1] - mu;
    float q = wave_sum(d0 * d0 + d1 * d1);
    if ((tid & 63) == 0) red[4 + (tid >> 6)] = q;
    __syncthreads();
    const float rstd = rsqrtf((red[4] + red[5] + red[6] + red[7]) * (1.f / DC) + EPS);
#pragma unroll
    for (int u = 0; u < 2; ++u) {
        const int c = tid + u * 256; const float v = (u ? d1 : d0) * rstd * lg[c] + lb[c];
        AC[(size_t)m * 1024 + 512 + c] = f2bf(silu_f(v));
    }
}
}

extern "C" void kernel_launch(void* const* d_in, const int* in_sizes, int n_in, void* d_out, int out_size, void* d_ws, size_t ws_size, hipStream_t stream) {
    (void)in_sizes; (void)n_in; (void)out_size; (void)ws_size;
    const float* x = (const float*)d_in[0]; const float* meta = (const float*)d_in[1];
    const float* f1n = (const float*)d_in[2]; const float* f1g = (const float*)d_in[3]; const float* f1u = (const float*)d_in[4]; const float* f1d = (const float*)d_in[5];
    const float* mixn = (const float*)d_in[6]; const float* win = (const float*)d_in[7];
    const float* lq1 = (const float*)d_in[8]; const float* lk1 = (const float*)d_in[9]; const float* lq2 = (const float*)d_in[10]; const float* lk2 = (const float*)d_in[11];
    const float* subw = (const float*)d_in[12]; const float* cw = (const float*)d_in[13]; const float* cb = (const float*)d_in[14]; const float* clg = (const float*)d_in[15]; const float* clb = (const float*)d_in[16];
    const float* wout = (const float*)d_in[17]; const float* f2n = (const float*)d_in[18]; const float* f2g = (const float*)d_in[19]; const float* f2u = (const float*)d_in[20]; const float* f2d = (const float*)d_in[21];
    const float* fng = (const float*)d_in[22];
    unsigned char* ws = (unsigned char*)d_ws; float* out = (float*)d_out;
    float* lamp = (float*)(ws + WS_CTL) + 1024; float2* rope = (float2*)(ws + WS_ROPE);
    float* ss1 = (float*)(ws + WS_SS); float* ss2 = ss1 + MP; float* ss3 = ss2 + MP; float* ss4 = ss3 + MP;
    float* XR = (float*)(ws + WS_XR); bf16_t* XB = (bf16_t*)(ws + WS_XB); bf16_t* ACT = (bf16_t*)(ws + WS_BIG);
    bf16_t* Q = (bf16_t*)(ws + WS_Q); bf16_t* Kb = (bf16_t*)(ws + WS_K); bf16_t* Vb = (bf16_t*)(ws + WS_V); bf16_t* Z = (bf16_t*)(ws + WS_Z); bf16_t* AC = (bf16_t*)(ws + WS_AC);

    nv::k_prep_rows<<<(RALL + 3) / 4, 256, 0, stream>>>(x, meta, XB, XR, ss1);
    nv::k_prep_misc<<<(LSEQ * 32 + 255) / 256, 256, 0, stream>>>(rope, lamp, lq1, lk1, lq2, lk2);
    const int rt_all = (RALL + 63) / 64, rt_m = M / 64;
    nv::k_gemm_gu<<<dim3(DFF / 64, rt_all), 256, 0, stream>>>(XB, f1g, f1u, f1n, ss1, ACT, RALL);
    nv::k_gemm_res<<<dim3(D / 64, rt_all), 256, 0, stream>>>(ACT, DFF, f1d, x, meta, 0.5f, XR, XB, RALL);
    nv::k_rowss<<<(RALL + 3) / 4, 256, 0, stream>>>(XR, ss2, RALL);
    nv::k_gemm_in<<<dim3(32, rt_all), 256, 0, stream>>>(XB, win, mixn, ss2, rope, Q, Kb, Vb, Z, RALL);
    nv::k_attn<<<dim3(S / 64, NH, NB), 256, 0, stream>>>(Q, Kb, Vb, subw, lamp, AC);
    nv::k_conv<<<M, 256, 0, stream>>>(Z, cw, cb, clg, clb, AC);
    nv::k_gemm_res<<<dim3(D / 64, rt_m), 256, 0, stream>>>(AC, D, wout, XR, XR, 1.0f, XR, XB, M);
    nv::k_rowss<<<M / 4, 256, 0, stream>>>(XR, ss3, M);
    nv::k_gemm_gu<<<dim3(DFF / 64, rt_m), 256, 0, stream>>>(XB, f2g, f2u, f2n, ss3, ACT, M);
    nv::k_gemm_res<<<dim3(D / 64, rt_m), 256, 0, stream>>>(ACT, DFF, f2d, XR, XR, 0.5f, out, nullptr, M);
    nv::k_rowss<<<M / 4, 256, 0, stream>>>(out, ss4, M);
    nv::k_final<<<M / 4, 256, 0, stream>>>(out, ss4, fng);
}
```

```cpp
#include <hip/hip_runtime.h>
#include <stdint.h>
#include <math.h>
#include <cstdio>
#include <cstdint>

typedef unsigned short bf16_t;
__device__ __forceinline__ float bf2f(bf16_t v) { return __uint_as_float(((unsigned)v) << 16); }
__device__ __forceinline__ bf16_t f2bf(float f) { unsigned u = __float_as_uint(f); return (bf16_t)((u + 0x7fffu + ((u >> 16) & 1u)) >> 16); }

constexpr int NB = 4, S = 8192, D = 1024, NMETA = 16, LSEQ = S + NMETA;
constexpr int M = NB * S;
constexpr int MP = M + 256;
constexpr int RALL = M + NMETA;
constexpr int DFF = 2816, DIN = 2560, DA = 512, DC = 512, HD = 64, NH = 4, CW = 31;
constexpr float EPS = 1e-5f;
constexpr float C2 = 0.125f * 1.4426950408889634f;
constexpr float LAMBDA_INIT = 0.2f;

constexpr size_t MiB = 1u << 20;
constexpr size_t WS_CTL = 0;
constexpr size_t WS_ROPE = 1 * MiB;
constexpr size_t WS_SS = 4 * MiB;
constexpr size_t WS_W = 6 * MiB;
constexpr size_t WS_XR = 48 * MiB;
constexpr size_t WS_XB = 178 * MiB;
constexpr size_t WS_BIG = 244 * MiB;
constexpr size_t SZ_QKVZ = (size_t)MP * 512 * 2;
constexpr size_t WS_Q = WS_BIG, WS_K = WS_Q + SZ_QKVZ, WS_V = WS_K + SZ_QKVZ, WS_Z = WS_V + SZ_QKVZ, WS_AC = WS_Z + SZ_QKVZ;
constexpr size_t WS_END = WS_AC + (size_t)MP * 1024 * 2;
static_assert(WS_BIG + (size_t)MP * DFF * 2 <= 512 * MiB && WS_END <= 512 * MiB, "ws map");

__device__ __forceinline__ int row_pos(int m) { return m < M ? (NMETA + (m & (S - 1))) : (m - M); }
__device__ __forceinline__ float wave_sum(float v) {
#pragma unroll
    for (int o = 1; o < 64; o <<= 1) v += __shfl_xor(v, o);
    return v;
}

namespace nv {
__global__ void __launch_bounds__(256) k_prep_rows(const float* __restrict__ x, const float* __restrict__ meta, bf16_t* XB, float* XR, float* ss1) {
    const int row = blockIdx.x * 4 + (threadIdx.x >> 6), lane = threadIdx.x & 63;
    if (row >= RALL) return;
    const float* src = row < M ? x + (size_t)row * D : meta + (size_t)(row - M) * D;
    float s = 0.f;
    for (int j = 0; j < 4; ++j) {
        const int c = j * 256 + lane * 4;
        const float4 v = *(const float4*)(src + c);
        s += v.x * v.x + v.y * v.y + v.z * v.z + v.w * v.w;
        bf16_t* o = XB + (size_t)row * D + c;
        o[0] = f2bf(v.x); o[1] = f2bf(v.y); o[2] = f2bf(v.z); o[3] = f2bf(v.w);
        if (row >= M) *(float4*)(XR + (size_t)row * D + c) = v;
    }
    s = wave_sum(s);
    if (lane == 0) ss1[row] = s;
}
__device__ __forceinline__ void sincos_d(double a, double& sn, double& cs) {
    const double TWO_OVER_PI = 0.63661977236758134308, PIO2_HI = 1.57079632679489655800e+00, PIO2_LO = 6.12323399573676603587e-17;
    const double kq = rint(a * TWO_OVER_PI);
    double y = fma(-kq, PIO2_HI, a); y = fma(-kq, PIO2_LO, y);
    const double y2 = y * y;
    double sp = -1.0 / 1307674368000.0;
    sp = fma(sp, y2, 1.0 / 6227020800.0);
    sp = fma(sp, y2, -1.0 / 39916800.0);
    sp = fma(sp, y2, 1.0 / 362880.0);
    sp = fma(sp, y2, -1.0 / 5040.0);
    sp = fma(sp, y2, 1.0 / 120.0);
    sp = fma(sp, y2, -1.0 / 6.0);
    const double sy = fma(sp * y2, y, y);
    double cp = 1.0 / 20922789888000.0;
    cp = fma(cp, y2, -1.0 / 87178291200.0);
    cp = fma(cp, y2, 1.0 / 479001600.0);
    cp = fma(cp, y2, -1.0 / 3628800.0);
    cp = fma(cp, y2, 1.0 / 40320.0);
    cp = fma(cp, y2, -1.0 / 720.0);
    cp = fma(cp, y2, 1.0 / 24.0);
    cp = fma(cp, y2, -0.5);
    const double cy = fma(cp, y2, 1.0);
    const long long q = (long long)kq & 3;
    sn = (q == 0) ? sy : (q == 1) ? cy : (q == 2) ? -sy : -cy;
    cs = (q == 0) ? cy : (q == 1) ? -sy : (q == 2) ? -cy : sy;
}
__global__ void __launch_bounds__(256) k_prep_misc(float2* rope, float* lamp, const float* q1, const float* k1, const float* q2, const float* k2) {
    const int idx = blockIdx.x * 256 + threadIdx.x;
    if (idx < LSEQ * 32) {
        const int pos = idx >> 5, i = idx & 31;
        const double inv = exp2(-(double)i * (13.287712379549449 / 32.0));
        double sn, cs; sincos_d((double)pos * inv, sn, cs);
        rope[idx] = make_float2((float)cs, (float)sn);
    }
    if (idx == 0) {
        float a = 0.f, b = 0.f;
        for (int i = 0; i < HD; ++i) { a += q1[i] * k1[i]; b += q2[i] * k2[i]; }
        lamp[0] = expf(a) - expf(b) + LAMBDA_INIT;
    }
}
__global__ void __launch_bounds__(256) k_rowss(const float* __restrict__ X, float* ss, int rows, int mbase) {
    const int row = mbase + blockIdx.x * 4 + (threadIdx.x >> 6), lane = threadIdx.x & 63;
    if (row >= rows) return;
    float s = 0.f;
    for (int j = 0; j < 4; ++j) { const float4 v = *(const float4*)(X + (size_t)row * D + j * 256 + lane * 4); s += v.x * v.x + v.y * v.y + v.z * v.z + v.w * v.w; }
    s = wave_sum(s);
    if (lane == 0) ss[row] = s;
}
__global__ void __launch_bounds__(256) k_final(float* out, const float* __restrict__ ss, const float* __restrict__ g) {
    const int row = blockIdx.x * 4 + (threadIdx.x >> 6), lane = threadIdx.x & 63;
    if (row >= M) return;
    const float rs = rsqrtf(ss[row] * (1.f / D) + EPS);
    for (int j = 0; j < 4; ++j) {
        const int c = j * 256 + lane * 4;
        float4 v = *(float4*)(out + (size_t)row * D + c); const float4 gv = *(const float4*)(g + c);
        v.x *= rs * gv.x; v.y *= rs * gv.y; v.z *= rs * gv.z; v.w *= rs * gv.w;
        *(float4*)(out + (size_t)row * D + c) = v;
    }
}

constexpr int TM = 64, TN = 64, TK = 16;
constexpr int SM_CORE = TK * (TM + 4) + 2 * TK * TN;
template <bool TWO>
__device__ __forceinline__ void core(const bf16_t* __restrict__ A, int lda, int rows, int K, const float* __restrict__ W0, const float* __restrict__ W1, int ldw, int na, int nb,
                                     const float* __restrict__ gain, int m0, float (&acc0)[4][4], float (&acc1)[4][4], float* sm) {
    float (*As)[TM + 4] = (float (*)[TM + 4])sm;
    float (*B0)[TN] = (float (*)[TN])(sm + TK * (TM + 4));
    float (*B1)[TN] = (float (*)[TN])(sm + TK * (TM + 4) + TK * TN);
    const int tid = threadIdx.x, tx = tid & 15, ty = tid >> 4;
#pragma unroll
    for (int i = 0; i < 4; ++i)
#pragma unroll
        for (int j = 0; j < 4; ++j) { acc0[i][j] = 0.f; acc1[i][j] = 0.f; }
    for (int k0 = 0; k0 < K; k0 += TK) {
        {
            const int r = tid >> 2, kq = (tid & 3) * 4, m = m0 + r;
            float a0 = 0.f, a1 = 0.f, a2 = 0.f, a3 = 0.f;
            if (m < rows) { const bf16_t* ap = A + (size_t)m * lda + k0 + kq; a0 = bf2f(ap[0]); a1 = bf2f(ap[1]); a2 = bf2f(ap[2]); a3 = bf2f(ap[3]); }
            As[kq + 0][r] = a0; As[kq + 1][r] = a1; As[kq + 2][r] = a2; As[kq + 3][r] = a3;
        }
        {
            const int kk = tid >> 4, nq = (tid & 15) * 4; const float gk = gain ? gain[k0 + kk] : 1.f;
            const float4 w = *(const float4*)(W0 + (size_t)(k0 + kk) * ldw + na + nq);
            B0[kk][nq + 0] = w.x * gk; B0[kk][nq + 1] = w.y * gk; B0[kk][nq + 2] = w.z * gk; B0[kk][nq + 3] = w.w * gk;
            if (TWO) {
                const float4 w1 = *(const float4*)(W1 + (size_t)(k0 + kk) * ldw + nb + nq);
                B1[kk][nq + 0] = w1.x * gk; B1[kk][nq + 1] = w1.y * gk; B1[kk][nq + 2] = w1.z * gk; B1[kk][nq + 3] = w1.w * gk;
            }
        }
        __syncthreads();
#pragma unroll
        for (int kk = 0; kk < TK; ++kk) {
            float a[4], b[4], c[4];
#pragma unroll
            for (int i = 0; i < 4; ++i) a[i] = As[kk][ty * 4 + i];
#pragma unroll
            for (int j = 0; j < 4; ++j) { b[j] = B0[kk][tx * 4 + j]; c[j] = TWO ? B1[kk][tx * 4 + j] : 0.f; }
#pragma unroll
            for (int i = 0; i < 4; ++i)
#pragma unroll
                for (int j = 0; j < 4; ++j) { acc0[i][j] = fmaf(a[i], b[j], acc0[i][j]); if (TWO) acc1[i][j] = fmaf(a[i], c[j], acc1[i][j]); }
        }
        __syncthreads();
    }
}
__device__ __forceinline__ float silu_f(float v) { return v / (1.f + __expf(-v)); }
__device__ __forceinline__ float sigm_f(float v) { return 1.f / (1.f + __expf(-v)); }

__global__ void __launch_bounds__(256) k_gemm_gu(const bf16_t* XB, const float* Wg, const float* Wu, const float* gain, const float* ss, bf16_t* ACT, int rows, int mbase) {
    __shared__ float sm[SM_CORE];
    float a0[4][4], a1[4][4];
    const int m0 = mbase + blockIdx.y * TM, n0 = blockIdx.x * TN;
    core<true>(XB, D, rows, D, Wg, Wu, DFF, n0, n0, gain, m0, a0, a1, sm);
    const int tx = threadIdx.x & 15, ty = threadIdx.x >> 4;
#pragma unroll
    for (int i = 0; i < 4; ++i) {
        const int m = m0 + ty * 4 + i; if (m >= rows) continue;
        const float rs = rsqrtf(ss[m] * (1.f / D) + EPS);
#pragma unroll
        for (int j = 0; j < 4; ++j) ACT[(size_t)m * DFF + n0 + tx * 4 + j] = f2bf(silu_f(a0[i][j] * rs) * (a1[i][j] * rs));
    }
}
__global__ void __launch_bounds__(256) k_gemm_res(const bf16_t* A, int K, const float* W, const float* resid, const float* resid_meta, float alpha, float* outf, bf16_t* outb, int rows, int mbase) {
    __shared__ float sm[SM_CORE];
    float a0[4][4], a1[4][4];
    const int m0 = mbase + blockIdx.y * TM, n0 = blockIdx.x * TN;
    core<false>(A, K, rows, K, W, nullptr, D, n0, 0, nullptr, m0, a0, a1, sm);
    const int tx = threadIdx.x & 15, ty = threadIdx.x >> 4;
#pragma unroll
    for (int i = 0; i < 4; ++i) {
        const int m = m0 + ty * 4 + i; if (m >= rows) continue;
        const float* rp = m < M ? resid + (size_t)m * D : resid_meta + (size_t)(m - M) * D;
#pragma unroll
        for (int j = 0; j < 4; ++j) {
            const int n = n0 + tx * 4 + j; const float v = rp[n] + alpha * a0[i][j];
            outf[(size_t)m * D + n] = v; if (outb) outb[(size_t)m * D + n] = f2bf(v);
        }
    }
}
__global__ void __launch_bounds__(256) k_gemm_in(const bf16_t* XB, const float* Win, const float* gain, const float* ss, const float2* rope, bf16_t* Q, bf16_t* Kb, bf16_t* Vb, bf16_t* Z, int rows, int mbase) {
    __shared__ float sm[SM_CORE];
    __shared__ float T[TM][TN + 1];
    float a0[4][4], a1[4][4];
    const int m0 = mbase + blockIdx.y * TM, lt = blockIdx.x;
    const int tx = threadIdx.x & 15, ty = threadIdx.x >> 4;
    if (lt < 24) core<false>(XB, D, rows, D, Win, nullptr, DIN, lt * 64, 0, gain, m0, a0, a1, sm);
    else core<true>(XB, D, rows, D, Win, Win, DIN, 1536 + (lt - 24) * 64, 2048 + (lt - 24) * 64, gain, m0, a0, a1, sm);
#pragma unroll
    for (int i = 0; i < 4; ++i) {
        const int m = m0 + ty * 4 + i; const float rs = m < rows ? rsqrtf(ss[m] * (1.f / D) + EPS) : 0.f;
#pragma unroll
        for (int j = 0; j < 4; ++j) { a0[i][j] *= rs; a1[i][j] *= rs; }
    }
    if (lt < 16) {
#pragma unroll
        for (int i = 0; i < 4; ++i)
#pragma unroll
            for (int j = 0; j < 4; ++j) T[ty * 4 + i][tx * 4 + j] = a0[i][j];
        __syncthreads();
        const int hs = lt & 7; bf16_t* O = lt < 8 ? Q : Kb; const float sc = lt < 8 ? C2 : 1.f;
        for (int e = threadIdx.x; e < 64 * 32; e += 256) {
            const int r = e >> 5, c = e & 31, m = m0 + r; if (m >= rows) continue;
            const float2 cs = rope[row_pos(m) * 32 + c]; const float x1 = T[r][c], x2 = T[r][c + 32];
            O[(size_t)m * 512 + hs * 64 + c] = f2bf((x1 * cs.x - x2 * cs.y) * sc);
            O[(size_t)m * 512 + hs * 64 + 32 + c] = f2bf((x2 * cs.x + x1 * cs.y) * sc);
        }
    } else {
#pragma unroll
        for (int i = 0; i < 4; ++i) {
            const int m = m0 + ty * 4 + i; if (m >= rows) continue;
#pragma unroll
            for (int j = 0; j < 4; ++j) {
                const int c = (lt & 7) * 64 + tx * 4 + j;
                if (lt < 24) Vb[(size_t)m * 512 + c] = f2bf(a0[i][j]); else Z[(size_t)m * 512 + c] = f2bf(a0[i][j] * sigm_f(a1[i][j]));
            }
        }
    }
}

__global__ void __launch_bounds__(256) k_attn(const bf16_t* __restrict__ Q, const bf16_t* __restrict__ Kb, const bf16_t* __restrict__ Vb, const float* __restrict__ subw, const float* __restrict__ lamp, bf16_t* AC) {
    __shared__ float Ks[64][64];
    __shared__ bf16_t Vs[64][128];
    __shared__ float Ps[64][65];
    const int qt = blockIdx.x, h = blockIdx.y, b = blockIdx.z;
    const int tid = threadIdx.x, r = tid >> 2, j = tid & 3;
    const int t = qt * 64 + r; const size_t mq = (size_t)b * S + t;
    const float lam = lamp[0];
    float o1[32];
#pragma unroll
    for (int c = 0; c < 32; ++c) o1[c] = 0.f;
    for (int sh = 0; sh < 2; ++sh) {
        const int s = 2 * h + sh;
        float q[64];
#pragma unroll
        for (int d = 0; d < 64; ++d) q[d] = bf2f(Q[mq * 512 + s * 64 + d]);
        float m_run = -INFINITY, l_run = 0.f; float o[32];
#pragma unroll
        for (int c = 0; c < 32; ++c) o[c] = 0.f;
        const int ntile = qt + 2;
        for (int kt = 0; kt < ntile; ++kt) {
            __syncthreads();
            for (int e = tid; e < 64 * 64; e += 256) {
                const int key = e >> 6, d = e & 63; const bool valid = kt == 0 ? key < NMETA : true;
                const size_t row = kt == 0 ? (size_t)(M + (key & 15)) : (size_t)b * S + (kt - 1) * 64 + key;
                Ks[key][d] = valid ? bf2f(Kb[row * 512 + s * 64 + d]) : 0.f;
            }
            for (int e = tid; e < 64 * 128; e += 256) {
                const int key = e >> 7, c = e & 127; const bool valid = kt == 0 ? key < NMETA : true;
                const size_t row = kt == 0 ? (size_t)(M + (key & 15)) : (size_t)b * S + (kt - 1) * 64 + key;
                Vs[key][c] = valid ? Vb[row * 512 + h * 128 + c] : (bf16_t)0;
            }
            __syncthreads();
            float sc[16]; float tmax = -INFINITY;
#pragma unroll
            for (int kk = 0; kk < 16; ++kk) {
                const int key = j * 16 + kk; float a = 0.f;
#pragma unroll
                for (int d = 0; d < 64; ++d) a = fmaf(q[d], Ks[key][d], a);
                const bool ok = kt == 0 ? key < NMETA : ((kt - 1) * 64 + key <= t);
                sc[kk] = ok ? a : -INFINITY; tmax = fmaxf(tmax, sc[kk]);
            }
            tmax = fmaxf(tmax, __shfl_xor(tmax, 1)); tmax = fmaxf(tmax, __shfl_xor(tmax, 2));
            const float m_new = fmaxf(m_run, tmax);
            const float alpha = exp2f(m_run - m_new);
            float psum = 0.f;
#pragma unroll
            for (int kk = 0; kk < 16; ++kk) { const float pv = exp2f(sc[kk] - m_new); psum += pv; Ps[r][j * 16 + kk] = pv; }
            psum += __shfl_xor(psum, 1); psum += __shfl_xor(psum, 2);
            l_run = l_run * alpha + psum; m_run = m_new;
            __syncthreads();
#pragma unroll
            for (int c = 0; c < 32; ++c) o[c] *= alpha;
            for (int key = 0; key < 64; ++key) {
                const float pv = Ps[r][key];
#pragma unroll
                for (int c = 0; c < 32; ++c) o[c] = fmaf(pv, bf2f(Vs[key][j * 32 + c]), o[c]);
            }
        }
        const float il = 1.f / l_run;
        if (sh == 0) {
#pragma unroll
            for (int c = 0; c < 32; ++c) o1[c] = o[c] * il;
        } else {
            float ssq = 0.f;
#pragma unroll
            for (int c = 0; c < 32; ++c) { o1[c] = o1[c] - lam * (o[c] * il); ssq += o1[c] * o1[c]; }
            ssq += __shfl_xor(ssq, 1); ssq += __shfl_xor(ssq, 2);
            const float rn = rsqrtf(ssq * (1.f / 128.f) + EPS) * (1.f - LAMBDA_INIT);
#pragma unroll
            for (int c = 0; c < 32; ++c) AC[mq * 1024 + h * 128 + j * 32 + c] = f2bf(o1[c] * rn * subw[j * 32 + c]);
        }
    }
}
__global__ void __launch_bounds__(256) k_conv(const bf16_t* __restrict__ Z, const float* __restrict__ cw, const float* __restrict__ cb, const float* __restrict__ lg, const float* __restrict__ lb, bf16_t* AC) {
    __shared__ float red[8];
    const int m = blockIdx.x, b = m / S, t = m % S, pos = NMETA + t, tid = threadIdx.x;
    float y[2];
#pragma unroll
    for (int u = 0; u < 2; ++u) {
        const int c = tid + u * 256; float a = cb[c];
        for (int j = 0; j < CW; ++j) {
            const int p = pos - (CW - 1) + j; if (p < 0) continue;
            const size_t row = p < NMETA ? (size_t)(M + p) : (size_t)b * S + (p - NMETA);
            a = fmaf(cw[j * DC + c], bf2f(Z[row * 512 + c]), a);
        }
        y[u] = a;
    }
    float s = wave_sum(y[0] + y[1]);
    if ((tid & 63) == 0) red[tid >> 6] = s;
    __syncthreads();
    const float mu = (red[0] + red[1] + red[2] + red[3]) * (1.f / DC);
    const float d0 = y[0] - mu, d1 = y[1] - mu;
    float q = wave_sum(d0 * d0 + d1 * d1);
    if ((tid & 63) == 0) red[4 + (tid >> 6)] = q;
    __syncthreads();
    const float rstd = rsqrtf((red[4] + red[5] + red[6] + red[7]) * (1.f / DC) + EPS);
#pragma unroll
    for (int u = 0; u < 2; ++u) {
        const int c = tid + u * 256; const float v = (u ? d1 : d0) * rstd * lg[c] + lb[c];
        AC[(size_t)m * 1024 + 512 + c] = f2bf(silu_f(v));
    }
}
}


namespace pg8 {
#define PG8_LAS __attribute__((address_space(3)))
typedef unsigned short bf16_t;
typedef short bf16x8 __attribute__((ext_vector_type(8)));
typedef float f32x4 __attribute__((ext_vector_type(4)));
typedef unsigned u32x4 __attribute__((ext_vector_type(4)));
constexpr int BM = 256, BK = 64, HALF = 128, HTB = HALF * BK * 2  , STAGE_BYTES = 8 * HTB, NXCD = 8, WGM = 8;

__host__ __device__ __forceinline__ int lds_byte(int r, int c) { const int st = (r >> 4) * 2 + (c >> 5), rr = r & 15, cc = c & 31, ob = rr * 64 + cc * 2; return st * 1024 + (ob ^ (((ob >> 9) & 1) << 5)); }
__host__ __device__ __forceinline__ void stage_rc(int b, int& R, int& C) { const int st = b / 1024, sb = b % 1024, swz = sb ^ (((sb >> 9) & 1) << 5); R = (st >> 1) * 16 + swz / 64; C = (st & 1) * 32 + (swz % 64) / 2; }
__host__ __device__ __forceinline__ int perm32(int rho) { const int n = rho >> 4, i = rho & 15; return 8 * (i >> 2) + 4 * n + (i & 3); }

struct Unit { int pm, pn; };
struct Gemm { const bf16_t* A; const bf16_t* Bt; int M, N, K; };

struct StaticOrder {
    int nM, nN, nwg, G, c;
    __host__ __device__ void init(int M, int N, int G_, int c_) { nM = M / BM; nN = N / BM; nwg = nM * nN; G = G_; c = c_; }
    __host__ __device__ bool next(int i, Unit& u) const {
        const long L = (long)i * G + c; if (L >= nwg) return false;
        int wgid = (int)L; { const int q = nwg / NXCD, r = nwg % NXCD, xcd = wgid % NXCD, off = wgid / NXCD; wgid = (xcd < r ? xcd * (q + 1) : r * (q + 1) + (xcd - r) * q) + off; }
        const int nig = WGM * nN, gid = wgid / nig, fm = gid * WGM, gsz = (nM - fm) < WGM ? (nM - fm) : WGM;
        u.pm = fm + ((wgid % nig) % gsz); u.pn = (wgid % nig) / gsz; return true;
    }
    __device__ __forceinline__ void a_ready(const Unit&) const {}
    __device__ __forceinline__ void done(const Unit&) const {}
};

__device__ __forceinline__ unsigned cvt_pk_bf16(float lo, float hi) { unsigned r; asm volatile("v_cvt_pk_bf16_f32 %0, %1, %2" : "=v"(r) : "v"(lo), "v"(hi)); return r; }
typedef unsigned u32x2 __attribute__((ext_vector_type(2)));
constexpr float EPI_EPS = 1e-5f, EPI_INVD = 1.0f / 1024.0f, EPI_LOG2E = 1.4426950408889634f;
__device__ __forceinline__ float fast_sigmoid(float v) { return __builtin_amdgcn_rcpf(1.0f + __builtin_amdgcn_exp2f(-EPI_LOG2E * v)); }

struct EpiGU {
    static constexpr bool PERM = true, AFTER_DRAIN = false;
    bf16_t* O; int ldo; const float* ss;
    __device__ __forceinline__ void operator()(const f32x4 (&acc)[2][2][4][2], const Unit& u, int wr, int wc, int fr, int fq) const {
        const int row0 = u.pm * BM + wr * 64 + fr, col0 = u.pn * HALF + wc * 32 + 8 * fq;
#pragma unroll
        for (int ai = 0; ai < 2; ++ai)
#pragma unroll
            for (int m = 0; m < 4; ++m) {
                const int row = row0 + ai * HALF + m * 16; const float rs = rsqrtf(ss[row] * EPI_INVD + EPI_EPS);
                float o[8];
#pragma unroll
                for (int n = 0; n < 2; ++n)
#pragma unroll
                    for (int i = 0; i < 4; ++i) { const float g = acc[ai][0][m][n][i] * rs, up = acc[ai][1][m][n][i] * rs; o[4 * n + i] = g * fast_sigmoid(g) * up; }
                u32x4 w; w.x = cvt_pk_bf16(o[0], o[1]); w.y = cvt_pk_bf16(o[2], o[3]); w.z = cvt_pk_bf16(o[4], o[5]); w.w = cvt_pk_bf16(o[6], o[7]);
                *(u32x4*)(O + (size_t)row * ldo + col0) = w;
            }
    }
};
struct EpiRes {
    static constexpr bool PERM = false, AFTER_DRAIN = false;
    const float* resid; float* outf; bf16_t* outb; float* ss; float alpha; int ldc;
    __device__ __forceinline__ void operator()(const f32x4 (&acc)[2][2][4][2], const Unit& u, int wr, int wc, int fr, int fq) const {
        const int row0 = u.pm * BM + wr * 64 + fr, col0 = u.pn * BM + wc * 32 + 4 * fq;
#pragma unroll
        for (int ai = 0; ai < 2; ++ai)
#pragma unroll
            for (int m = 0; m < 4; ++m) {
                const int row = row0 + ai * HALF + m * 16; const size_t off = (size_t)row * ldc + col0; float q = 0.f;
#pragma unroll
                for (int bj = 0; bj < 2; ++bj)
#pragma unroll
                    for (int n = 0; n < 2; ++n) {
                        const f32x4 rv = *(const f32x4*)(resid + off + bj * HALF + n * 16);
                        const f32x4 v = rv + acc[ai][bj][m][n] * alpha;
                        *(f32x4*)(outf + off + bj * HALF + n * 16) = v;
                        q += (v[0] * v[0] + v[1] * v[1]) + (v[2] * v[2] + v[3] * v[3]);
                        if (outb) { u32x2 w; w.x = cvt_pk_bf16(v[0], v[1]); w.y = cvt_pk_bf16(v[2], v[3]); *(u32x2*)(outb + off + bj * HALF + n * 16) = w; }
                    }
                q += __shfl_xor(q, 16); q += __shfl_xor(q, 32);
                if (fq == 0) atomicAdd(ss + row, q);
                asm volatile("" ::: "memory");
            }
    }
};
struct EpiIn {
    static constexpr bool PERM = true, AFTER_DRAIN = false;
    bf16_t *Q, *K, *V, *Z; const float* ss; const float* rope; float qscale;
    __device__ __forceinline__ void operator()(const f32x4 (&acc)[2][2][4][2], const Unit& u, int wr, int wc, int fr, int fq) const {
        const int row0 = u.pm * BM + wr * 64 + fr, pn = u.pn, j0 = wc * 32 + 8 * fq;
#pragma unroll
        for (int ai = 0; ai < 2; ++ai)
#pragma unroll
            for (int m = 0; m < 4; ++m) {
                const int row = row0 + ai * HALF + m * 16; const float rs = rsqrtf(ss[row] * EPI_INVD + EPI_EPS);
                float x0[8], x1[8];
#pragma unroll
                for (int n = 0; n < 2; ++n)
#pragma unroll
                    for (int i = 0; i < 4; ++i) { x0[4 * n + i] = acc[ai][0][m][n][i] * rs; x1[4 * n + i] = acc[ai][1][m][n][i] * rs; }
                u32x4 w0, w1;
                if (pn < 4) {
                    const int pos = 16 + (row & 8191); const float sc = pn < 2 ? qscale : 1.0f;
                    const f32x4* rp = (const f32x4*)(rope + ((size_t)pos * 32 + 8 * fq) * 2);
                    float o0[8], o1[8];
#pragma unroll
                    for (int p = 0; p < 4; ++p) { const f32x4 cs = rp[p];
                        o0[2 * p] = (x0[2 * p] * cs[0] - x1[2 * p] * cs[1]) * sc; o1[2 * p] = (x1[2 * p] * cs[0] + x0[2 * p] * cs[1]) * sc;
                        o0[2 * p + 1] = (x0[2 * p + 1] * cs[2] - x1[2 * p + 1] * cs[3]) * sc; o1[2 * p + 1] = (x1[2 * p + 1] * cs[2] + x0[2 * p + 1] * cs[3]) * sc; }
                    w0.x = cvt_pk_bf16(o0[0], o0[1]); w0.y = cvt_pk_bf16(o0[2], o0[3]); w0.z = cvt_pk_bf16(o0[4], o0[5]); w0.w = cvt_pk_bf16(o0[6], o0[7]);
                    w1.x = cvt_pk_bf16(o1[0], o1[1]); w1.y = cvt_pk_bf16(o1[2], o1[3]); w1.z = cvt_pk_bf16(o1[4], o1[5]); w1.w = cvt_pk_bf16(o1[6], o1[7]);
                    bf16_t* O = (pn < 2 ? Q : K) + (size_t)row * 512 + ((pn & 1) * 4 + wc) * 64 + 8 * fq;
                    *(u32x4*)O = w0; *(u32x4*)(O + 32) = w1;
                } else if (pn < 6) {
                    w0.x = cvt_pk_bf16(x0[0], x0[1]); w0.y = cvt_pk_bf16(x0[2], x0[3]); w0.z = cvt_pk_bf16(x0[4], x0[5]); w0.w = cvt_pk_bf16(x0[6], x0[7]);
                    w1.x = cvt_pk_bf16(x1[0], x1[1]); w1.y = cvt_pk_bf16(x1[2], x1[3]); w1.z = cvt_pk_bf16(x1[4], x1[5]); w1.w = cvt_pk_bf16(x1[6], x1[7]);
                    bf16_t* O = V + (size_t)row * 512 + (pn - 4) * 256 + j0;
                    *(u32x4*)O = w0; *(u32x4*)(O + HALF) = w1;
                } else {
                    float o[8];
#pragma unroll
                    for (int e = 0; e < 8; ++e) o[e] = x0[e] * fast_sigmoid(x1[e]);
                    w0.x = cvt_pk_bf16(o[0], o[1]); w0.y = cvt_pk_bf16(o[2], o[3]); w0.z = cvt_pk_bf16(o[4], o[5]); w0.w = cvt_pk_bf16(o[6], o[7]);
                    *(u32x4*)(Z + (size_t)row * 512 + (pn - 6) * HALF + j0) = w0;
                }
            }
    }
};

template <class Epi, class Sched, bool ALIGN_EPI = false, bool SP2 = false>
__device__ __forceinline__ void gemm_phase(PG8_LAS unsigned char* lds, const Gemm g, const Sched& S, const Epi& E) {
    int tid_ = threadIdx.x; asm volatile("" : "+v"(tid_));
    const int tid = tid_, wid = __builtin_amdgcn_readfirstlane(tid >> 6), lane = tid & 63, wr = wid >> 2, wc = wid & 3, fr = lane & 15, fq = lane >> 4;
    const int K = g.K, nt = K / BK;
    unsigned voffA[2], voffB[2];
#pragma unroll
    for (int i = 0; i < 2; ++i) { int R, C; stage_rc(tid * 16 + i * 8192, R, C); const int Rb = Epi::PERM ? ((R & ~31) + perm32(R & 31)) : R;
        voffA[i] = (unsigned)(R * K + C) * 2u; voffB[i] = (unsigned)(Rb * K + C) * 2u; }
    const size_t kstep = (size_t)(BK * 2);
    const size_t hstep = (size_t)HALF * K * 2;
    const size_t tstep = 2 * hstep;
    const unsigned ldsw = (unsigned)wid * 1024u;
    const int aoff = lds_byte(wr * 64 + fr, fq * 8), boff = lds_byte(wc * 32 + fr, fq * 8);
#define PG8_SA(b, h) (((b) * 2 + (h)) * HTB)
#define PG8_SB(b, h) ((4 + (b) * 2 + (h)) * HTB)
#define PG8_STAGE(bufoff, gbase, voff) do { _Pragma("unroll") for (int _i = 0; _i < 2; ++_i) \
        __builtin_amdgcn_global_load_lds((const unsigned*)((const char*)(gbase) + (voff)[_i]), (PG8_LAS unsigned*)(lds + (bufoff) + ldsw + _i * 8192), 16, 0, 0); } while (0)
#define PG8_LDA(dst, b, h) do { _Pragma("unroll") for (int m = 0; m < 4; ++m) _Pragma("unroll") for (int k = 0; k < 2; ++k) dst[m][k] = *(const PG8_LAS bf16x8*)(lds + PG8_SA(b, h) + aoff + m * 2048 + k * 1024); } while (0)
#define PG8_LDB(dst, b, h) do { _Pragma("unroll") for (int n = 0; n < 2; ++n) _Pragma("unroll") for (int k = 0; k < 2; ++k) dst[n][k] = *(const PG8_LAS bf16x8*)(lds + PG8_SB(b, h) + boff + n * 2048 + k * 1024); } while (0)
#define PG8_MMA(ai, bj, At, Bt) do { __builtin_amdgcn_s_setprio(1); _Pragma("unroll") for (int m = 0; m < 4; ++m) _Pragma("unroll") for (int n = 0; n < 2; ++n) _Pragma("unroll") for (int k = 0; k < 2; ++k) \
        acc[ai][bj][m][n] = __builtin_amdgcn_mfma_f32_16x16x32_bf16(Bt[n][k], At[m][k], acc[ai][bj][m][n], 0, 0, 0); __builtin_amdgcn_s_setprio(0); } while (0)
#define PG8_WAIT_V(n) asm volatile("s_waitcnt vmcnt(" #n ")" ::: "memory")
#define PG8_WAIT_L(n) asm volatile("s_waitcnt lgkmcnt(" #n ")" ::: "memory")
#define PG8_BAR __builtin_amdgcn_s_barrier()
#define PG8_SCHED __builtin_amdgcn_sched_barrier(0)
    Unit cur, nxt; int ui = 0;
    if (!S.next(0, cur)) return;
    f32x4 acc[2][2][4][2];
#pragma unroll
    for (int a = 0; a < 2; ++a)
#pragma unroll
        for (int b = 0; b < 2; ++b)
#pragma unroll
            for (int m = 0; m < 4; ++m)
#pragma unroll
                for (int n = 0; n < 2; ++n) acc[a][b][m][n] = (f32x4){0.f, 0.f, 0.f, 0.f};
    bf16x8 At[4][2], B0[2][2], B1[2][2];
    const char* cA = (const char*)g.A + (size_t)cur.pm * tstep; const char* cB = (const char*)g.Bt + (size_t)cur.pn * tstep;
    S.a_ready(cur);
    if constexpr (SP2) {
        PG8_STAGE(PG8_SB(0, 0), cB, voffB); PG8_STAGE(PG8_SB(0, 1), cB + hstep, voffB); PG8_STAGE(PG8_SA(0, 0), cA, voffA); PG8_STAGE(PG8_SA(0, 1), cA + hstep, voffA);
        if (wr == 1) PG8_BAR;
        PG8_WAIT_V(2); PG8_BAR;
        PG8_STAGE(PG8_SB(1, 0), cB + kstep, voffB); PG8_STAGE(PG8_SA(1, 0), cA + kstep, voffA); PG8_STAGE(PG8_SB(1, 1), cB + hstep + kstep, voffB);
        PG8_WAIT_V(6); PG8_BAR;
    } else {
        PG8_STAGE(PG8_SB(0, 0), cB, voffB); PG8_STAGE(PG8_SA(0, 0), cA, voffA); PG8_STAGE(PG8_SB(0, 1), cB + hstep, voffB); PG8_STAGE(PG8_SA(0, 1), cA + hstep, voffA);
        if (wr == 1) PG8_BAR;
        PG8_WAIT_V(4); PG8_BAR;
        PG8_STAGE(PG8_SB(1, 0), cB + kstep, voffB); PG8_STAGE(PG8_SA(1, 0), cA + kstep, voffA); PG8_STAGE(PG8_SB(1, 1), cB + hstep + kstep, voffB);
        PG8_WAIT_V(6); PG8_BAR;
    }
    for (;;) {
        const bool has_next = S.next(ui + 1, nxt);
        const char* nA = has_next ? (const char*)g.A + (size_t)nxt.pm * tstep : cA; const char* nB = has_next ? (const char*)g.Bt + (size_t)nxt.pn * tstep : cB;
        for (int t = 0; t < nt; t += 2) {
            const bool last = (t == nt - 2);
            const char* a1 = cA + (size_t)(t + 1) * kstep;
            const char* a2 = last ? nA : cA + (size_t)(t + 2) * kstep; const char* b2 = last ? nB : cB + (size_t)(t + 2) * kstep;
            const char* a3 = a2 + kstep; const char* b3 = b2 + kstep;
            if (last && has_next) S.a_ready(nxt);
            if constexpr (SP2) {
            PG8_LDB(B0, 0, 0); PG8_LDB(B1, 0, 1); PG8_SCHED; PG8_LDA(At, 0, 0); PG8_STAGE(PG8_SA(1, 1), a1 + hstep, voffA);
            PG8_WAIT_V(8); PG8_WAIT_L(0); PG8_BAR; PG8_MMA(0, 0, At, B0); PG8_MMA(0, 1, At, B1); PG8_BAR; PG8_SCHED;
            PG8_LDA(At, 0, 1); PG8_STAGE(PG8_SB(0, 0), b2, voffB); PG8_STAGE(PG8_SB(0, 1), b2 + hstep, voffB); PG8_STAGE(PG8_SA(0, 0), a2, voffA);
            PG8_WAIT_V(8); PG8_WAIT_L(0); PG8_BAR; PG8_MMA(1, 0, At, B0); PG8_MMA(1, 1, At, B1); PG8_BAR; PG8_SCHED;
            PG8_LDB(B0, 1, 0); PG8_LDB(B1, 1, 1); PG8_SCHED; PG8_LDA(At, 1, 0); PG8_STAGE(PG8_SA(0, 1), a2 + hstep, voffA);
            PG8_WAIT_V(8); PG8_WAIT_L(0); PG8_BAR; PG8_MMA(0, 0, At, B0); PG8_MMA(0, 1, At, B1); PG8_BAR; PG8_SCHED;
            PG8_LDA(At, 1, 1); PG8_STAGE(PG8_SB(1, 0), b3, voffB); PG8_STAGE(PG8_SB(1, 1), b3 + hstep, voffB); PG8_STAGE(PG8_SA(1, 0), a3, voffA);
            PG8_WAIT_V(8); PG8_WAIT_L(0); PG8_BAR; PG8_MMA(1, 0, At, B0); PG8_MMA(1, 1, At, B1); PG8_BAR; PG8_SCHED;
            } else {
            PG8_LDB(B0, 0, 0); PG8_SCHED; PG8_LDA(At, 0, 0); PG8_STAGE(PG8_SA(1, 1), a1 + hstep, voffA);
            PG8_WAIT_L(8); PG8_BAR; PG8_WAIT_L(0); PG8_MMA(0, 0, At, B0); PG8_BAR; PG8_SCHED;
            PG8_LDB(B1, 0, 1); PG8_STAGE(PG8_SB(0, 0), b2, voffB);
            PG8_BAR; PG8_WAIT_L(0); PG8_MMA(0, 1, At, B1); PG8_BAR;
            PG8_LDA(At, 0, 1); PG8_STAGE(PG8_SA(0, 0), a2, voffA);
            PG8_BAR; PG8_WAIT_L(0); PG8_MMA(1, 0, At, B0); PG8_BAR; PG8_SCHED;
            PG8_STAGE(PG8_SB(0, 1), b2 + hstep, voffB);
            PG8_WAIT_V(6); PG8_BAR; PG8_MMA(1, 1, At, B1); PG8_BAR;
            PG8_LDB(B0, 1, 0); PG8_SCHED; PG8_LDA(At, 1, 0); PG8_STAGE(PG8_SA(0, 1), a2 + hstep, voffA);
            PG8_WAIT_L(8); PG8_BAR; PG8_WAIT_L(0); PG8_MMA(0, 0, At, B0); PG8_BAR; PG8_SCHED;
            PG8_LDB(B1, 1, 1); PG8_STAGE(PG8_SB(1, 0), b3, voffB);
            PG8_BAR; PG8_WAIT_L(0); PG8_MMA(0, 1, At, B1); PG8_BAR;
            PG8_LDA(At, 1, 1); PG8_STAGE(PG8_SA(1, 0), a3, voffA);
            PG8_BAR; PG8_WAIT_L(0); PG8_MMA(1, 0, At, B0); PG8_BAR; PG8_SCHED;
            PG8_STAGE(PG8_SB(1, 1), b3 + hstep, voffB);
            PG8_WAIT_V(6); PG8_BAR; PG8_MMA(1, 1, At, B1); PG8_BAR;
            }
        }
        if constexpr (ALIGN_EPI) { if (wr == 0) PG8_BAR; }
        if constexpr (!Epi::AFTER_DRAIN) { E(acc, cur, wr, wc, fr, fq); S.done(cur); }
        if (!has_next) break;
#pragma unroll
        for (int a = 0; a < 2; ++a)
#pragma unroll
            for (int b = 0; b < 2; ++b)
#pragma unroll
                for (int m = 0; m < 4; ++m)
#pragma unroll
                    for (int n = 0; n < 2; ++n) acc[a][b][m][n] = (f32x4){0.f, 0.f, 0.f, 0.f};
        cur = nxt; cA = nA; cB = nB; ++ui;
        if constexpr (ALIGN_EPI) { if (wr == 1) PG8_BAR; }
    }
    PG8_WAIT_V(0);
    if constexpr (!ALIGN_EPI) { if (wr == 0) PG8_BAR; }
    PG8_BAR;
    if constexpr (Epi::AFTER_DRAIN) { E.fused(acc, cur, wr, wc, fr, fq, lds, wid, lane); S.done(cur); }
#undef PG8_SA
#undef PG8_SB
#undef PG8_STAGE
#undef PG8_LDA
#undef PG8_LDB
#undef PG8_MMA
#undef PG8_WAIT_V
#undef PG8_WAIT_L
#undef PG8_BAR
#undef PG8_SCHED
}
}

#ifndef PG8_SP2
#define PG8_SP2 true
#endif
#ifndef PG8_ALIGN
#define PG8_ALIGN true
#endif

#include <hip/hip_bf16.h>
namespace attn_body {
using bf16=__hip_bfloat16;
using bf16x8=__attribute__((ext_vector_type(8)))short;
using s16x4=__attribute__((ext_vector_type(4)))short;
using f32x16=__attribute__((ext_vector_type(16)))float;
using u32x4=__attribute__((ext_vector_type(4)))unsigned;
constexpr int PITCH=512;
constexpr int OPITCH=1024;
constexpr int NW=8,QBLK=32,QB=QBLK*NW,KVBLK=64;
__device__ __forceinline__ int crow(int r,int hi){return (r&3)+8*(r>>2)+4*hi;}
#define SBAR() __builtin_amdgcn_sched_barrier(0)
__device__ __forceinline__ void cmask(f32x16&p0,f32x16&p1,int jb,int qrel,int hi){
  const float NEG=-INFINITY; int kb=64*jb+4*hi;
  #pragma unroll
  for(int r=0;r<16;++r){int kv=kb+(r&3)+8*(r>>2); if(kv>qrel)p0[r]=NEG; if(kv+32>qrel)p1[r]=NEG;}
}
__device__ __forceinline__ void metamask(f32x16&p0,f32x16&p1){
  const float NEG=-INFINITY;
  #pragma unroll
  for(int r=0;r<16;++r){ if(r>=8)p0[r]=NEG; p1[r]=NEG; }
}

constexpr int NSLOT=3, SLOTB=8192;
constexpr int LDS_K=0, LDS_V=NSLOT*SLOTB, LDS_WS=2*NSLOT*SLOTB, LDS_OST=LDS_WS+NW*128*4, LDS_BYTES=LDS_OST+NW*4096;
__device__ __forceinline__ void glds16(const void*gsrc,unsigned lds_dst){unsigned keep;
  asm volatile("s_mov_b32 %0, m0\n\ts_mov_b32 m0, %2\n\ts_nop 0\n\tglobal_load_lds_dwordx4 %1, off\n\ts_mov_b32 m0, %0":"=&s"(keep):"v"(gsrc),"s"(lds_dst):"memory");}
__device__ __forceinline__ float max3f(float a,float b,float c){float r;asm("v_max3_f32 %0, %1, %2, %3":"=v"(r):"v"(a),"v"(b),"v"(c));return r;}
__device__ __forceinline__ float max2f(float a,float b){float r;asm("v_max_f32_e32 %0, %1, %2":"=v"(r):"v"(a),"v"(b));return r;}
__device__ __forceinline__ float fadd_s(float a,float b){float r;asm("v_add_f32_e32 %0, %1, %2":"=v"(r):"v"(a),"v"(b));return r;}
__device__ __forceinline__ float fsub_s(float a,float b){float r;asm("v_sub_f32_e32 %0, %1, %2":"=v"(r):"v"(a),"v"(b));return r;}
typedef float f32x2_t __attribute__((ext_vector_type(2))); typedef __bf16 bf16x2_t __attribute__((ext_vector_type(2)));
__device__ __forceinline__ unsigned cvtpk_s(float lo,float hi){f32x2_t v={lo,hi};bf16x2_t b=__builtin_convertvector(v,bf16x2_t);return __builtin_bit_cast(unsigned,b);}
#define WAIT_BAR(N) asm volatile("s_waitcnt vmcnt(" #N ") lgkmcnt(0)\n\ts_barrier":::"memory")

__device__ __forceinline__ void qkt(f32x16&p0,f32x16&p1,const char*Kslot,const bf16x8*qr,const f32x16&negm,int r32,int hi){
  const char*kb=Kslot+hi*1024+r32*16;
  #pragma unroll
  for(int d0=0;d0<4;++d0){
    const bf16x8 b0=*reinterpret_cast<const bf16x8*>(kb+d0*2048);
    const bf16x8 b1=*reinterpret_cast<const bf16x8*>(kb+d0*2048+512);
    if(d0==0){p0=__builtin_amdgcn_mfma_f32_32x32x16_bf16(b0,qr[0],negm,0,0,0);p1=__builtin_amdgcn_mfma_f32_32x32x16_bf16(b1,qr[0],negm,0,0,0);}
    else{p0=__builtin_amdgcn_mfma_f32_32x32x16_bf16(b0,qr[d0],p0,0,0,0);p1=__builtin_amdgcn_mfma_f32_32x32x16_bf16(b1,qr[d0],p1,0,0,0);}}
}
typedef __attribute__((address_space(3))) const char* lds_cptr;
typedef short v4i16_t __attribute__((ext_vector_type(4)));
__device__ __forceinline__ void kload8(bf16x8*kf,lds_cptr kp){
  kf[0]=*(const __attribute__((address_space(3))) bf16x8*)(kp);      kf[1]=*(const __attribute__((address_space(3))) bf16x8*)(kp+512);
  kf[2]=*(const __attribute__((address_space(3))) bf16x8*)(kp+2048); kf[3]=*(const __attribute__((address_space(3))) bf16x8*)(kp+2560);
  kf[4]=*(const __attribute__((address_space(3))) bf16x8*)(kp+4096); kf[5]=*(const __attribute__((address_space(3))) bf16x8*)(kp+4608);
  kf[6]=*(const __attribute__((address_space(3))) bf16x8*)(kp+6144); kf[7]=*(const __attribute__((address_space(3))) bf16x8*)(kp+6656);
}
__device__ __forceinline__ void kload2(bf16x8*kf,lds_cptr kp,int j){ kf[2*j]=*(const __attribute__((address_space(3))) bf16x8*)(kp+j*2048); kf[2*j+1]=*(const __attribute__((address_space(3))) bf16x8*)(kp+j*2048+512); }
__device__ __forceinline__ s16x4 vtr(lds_cptr p){ return __builtin_bit_cast(s16x4,__builtin_amdgcn_ds_read_tr16_b64_v4i16((__attribute__((address_space(3))) v4i16_t*)p)); }
__device__ __forceinline__ float rowmax(const f32x16&p0,const f32x16&p1){
  float a=max3f(p0[0],p0[1],p1[0]),b=max3f(p0[2],p0[3],p1[1]);a=max3f(a,p1[2],p1[3]);
  #pragma unroll
  for(int r=4;r<16;r+=4){a=max3f(a,p0[r],p0[r+1]);b=max3f(b,p0[r+2],p0[r+3]);a=max3f(a,p1[r],p1[r+1]);b=max3f(b,p1[r+2],p1[r+3]);}
  const float m=max2f(a,b);
  auto rr=__builtin_amdgcn_permlane32_swap(__float_as_uint(m),__float_as_uint(m),false,false);
  return max2f(__uint_as_float(rr[0]),__uint_as_float(rr[1]));
}
__device__ __forceinline__ void pv(f32x16*o,int vb,bf16x8 pa0,bf16x8 pa1,bf16x8 pa2,bf16x8 pa3){
  #pragma unroll
  for(int d0=0;d0<2;++d0){s16x4 lo[4],hi[4];
    #pragma unroll
    for(int ks=0;ks<4;++ks){
      asm volatile("ds_read_b64_tr_b16 %0,%1 offset:%c2":"=&v"(lo[ks]):"v"(vb),"i"(d0*4096+ks*1024):"memory");
      asm volatile("ds_read_b64_tr_b16 %0,%1 offset:%c2":"=&v"(hi[ks]):"v"(vb),"i"(d0*4096+ks*1024+512):"memory");}
    asm volatile("s_waitcnt lgkmcnt(0)":::"memory");SBAR();
    #define PK(k) (bf16x8){lo[k][0],lo[k][1],lo[k][2],lo[k][3],hi[k][0],hi[k][1],hi[k][2],hi[k][3]}
    o[d0]=__builtin_amdgcn_mfma_f32_32x32x16_bf16(pa0,PK(0),o[d0],0,0,0);
    o[d0]=__builtin_amdgcn_mfma_f32_32x32x16_bf16(pa1,PK(1),o[d0],0,0,0);
    o[d0]=__builtin_amdgcn_mfma_f32_32x32x16_bf16(pa2,PK(2),o[d0],0,0,0);
    o[d0]=__builtin_amdgcn_mfma_f32_32x32x16_bf16(pa3,PK(3),o[d0],0,0,0);
    #undef PK
  }
}
__device__ __forceinline__ float half_sum(float v){
  v+=__shfl_xor(v,1);v+=__shfl_xor(v,2);v+=__shfl_xor(v,4);v+=__shfl_xor(v,8);v+=__shfl_xor(v,16);return v;}

struct PassArgs {
  const bf16* Qw;
  const bf16* Kreal;
  const bf16* Kmeta;
  const bf16* Vreal;
  const bf16* Vmeta;
  float* SC;
  bf16* Ow;
  const float* subw;
  float lam;
  int qb, vh, mode;
};
template<int THRL> __device__ __forceinline__ void attn_pass(const PassArgs&A,char*shm){
  int tid_=threadIdx.x; asm volatile("":"+v"(tid_));
  const int tid=tid_,lane=tid&63,r32=lane&31,hi=lane>>5; const int wid=__builtin_amdgcn_readfirstlane(tid>>6);
  const int qb=A.qb;
  const bf16*Qw=A.Qw+(long)(wid*QBLK)*PITCH;
  const unsigned lds0=(unsigned)(uintptr_t)shm;
  float*wsf=(float*)(shm+LDS_WS)+wid*128;
  const bf16*ksrc=A.Kreal+(long)lane*PITCH+wid*8-(long)KVBLK*PITCH;
  const bf16*ksrc0=A.Kmeta+(long)lane*PITCH+wid*8;
  const bf16*vsrc=A.Vreal+(long)(16*(wid&3)+(lane>>2))*PITCH+(wid>>2)*32+(lane&3)*8-(long)KVBLK*PITCH;
  const bf16*vsrc0=A.Vmeta+(long)(16*(wid&3)+(lane>>2))*PITCH+(wid>>2)*32+(lane&3)*8;
  const unsigned kdst=lds0+LDS_K+wid*1024, vdst=lds0+LDS_V+wid*1024;
  #define DMA_K(t,slot) glds16(ksrc+(long)(t)*KVBLK*PITCH,(unsigned)__builtin_amdgcn_readfirstlane(kdst+(slot)))
  #define DMA_V(t,slot) glds16(vsrc+(long)(t)*KVBLK*PITCH,(unsigned)__builtin_amdgcn_readfirstlane(vdst+(slot)))
  #define DMA_K0(slot) glds16(ksrc0,(unsigned)__builtin_amdgcn_readfirstlane(kdst+(slot)))
  #define DMA_V0(slot) glds16(vsrc0,(unsigned)__builtin_amdgcn_readfirstlane(vdst+(slot)))
  const int vb0=(int)(lds0+LDS_V)+((lane>>4)&1)*32+(lane&3)*8+(4*hi+((lane&15)>>2))*64;
  const char*Kbase=shm+LDS_K; bf16x8 kf[8];
  const lds_cptr shm3=(lds_cptr)shm; const lds_cptr kp0=shm3+LDS_K+hi*1024+r32*16; const lds_cptr vp0=shm3+LDS_V+((lane>>4)&1)*32+(lane&3)*8+(4*hi+((lane&15)>>2))*64;
  const int NT=4*qb+5;
  DMA_K0(0);DMA_V0(0);DMA_K(1,SLOTB);
  bf16x8 qr[4];
  #pragma unroll
  for(int d0=0;d0<4;++d0)qr[d0]=*reinterpret_cast<const bf16x8*>(&Qw[(long)r32*PITCH+d0*16+hi*8]);
  float mhat=0.f,l_reg=0.f;f32x16 o[2];o[0]=f32x16{};o[1]=f32x16{};f32x16 negm;
  #pragma unroll
  for(int r=0;r<16;++r){float z_;asm volatile("v_mov_b32 %0, 0":"=v"(z_));negm[r]=z_;}
  asm volatile("":"+v"(negm));
  const int qrel=wid*QBLK+r32;
  #define CMASK(P0,P1,t) do{int jb_=(t)-(NT-4); if(jb_>=0)cmask(P0,P1,jb_,qrel,hi);}while(0)
  bool resc=false;
  #define START(P0,P1) do{ const float rm=rowmax(P0,P1); resc=false; \
    { const float dl=rm; mhat=fadd_s(mhat,dl); \
      _Pragma("unroll") for(int r=0;r<16;++r){P0[r]=fsub_s(P0[r],dl);P1[r]=fsub_s(P1[r],dl);} \
      _Pragma("unroll") for(int r=0;r<16;++r)negm[r]=-mhat; asm volatile("":"+v"(negm)); } \
    _Pragma("unroll") for(int r=0;r<16;++r)P0[r]=__builtin_amdgcn_exp2f(P0[r]); }while(0)
  #define RESC() do{ if(resc){ asm volatile("s_waitcnt lgkmcnt(0)":::"memory"); \
      _Pragma("unroll") for(int d_=0;d_<2;++d_) _Pragma("unroll") for(int r=0;r<16;++r)o[d_][r]*=wsf[crow(r,hi)]; } }while(0)
  f32x16 pA0,pA1,pB0,pB1;
  int sl_prev=0,sl_cur=0,sl_next=SLOTB;
  #define ROT() do{sl_prev=sl_cur;sl_cur=sl_next;sl_next=(sl_next==(NSLOT-1)*SLOTB)?0:sl_next+SLOTB;}while(0)
  DMA_K(2,2*SLOTB);
  WAIT_BAR(3);
  qkt(pA0,pA1,Kbase,qr,negm,r32,hi);asm volatile("s_nop 15\n\ts_nop 7":"+v"(pA0),"+v"(pA1));metamask(pA0,pA1);
  START(pA0,pA1);
  _Pragma("unroll") for(int r=0;r<16;++r)pA1[r]=__builtin_amdgcn_exp2f(pA1[r]);
  WAIT_BAR(0);
  DMA_K(3,0);DMA_V(1,SLOTB);
  ROT();
  kload8(kf,kp0+sl_cur);
  WAIT_BAR(2);
  s16x4 vlo[8],vhi[8]; u32x4 pw0,pw1,pw2,pw3;
  #define PKW(P,B) cvtpk_s(P[B],P[B+1])
  #define PAF(k) __builtin_bit_cast(bf16x8,pw##k)
  #define VFR(i) (bf16x8){vlo[i][0],vlo[i][1],vlo[i][2],vlo[i][3],vhi[i][0],vhi[i][1],vhi[i][2],vhi[i][3]}
  #define PIN(x) asm volatile("":"+v"(x))
  #define MX3(a,b,c) __builtin_fmaxf(__builtin_fmaxf((a),(b)),(c))
  #define GAPA(MF,A0,A1,A2,A3,W0,W1,PW) do{ MF; sacc+=A0; sacc+=A1; sacc+=A2; sacc+=A3; PIN(sacc); W0; W1; PIN(PW); SBAR(); }while(0)
  #define EX(v) __builtin_amdgcn_exp2f(v)
  #define GAPB(MF,X,B) do{ MF; X[B]=EX(X[B]); X[B+1]=EX(X[B+1]); X[B+2]=EX(X[B+2]); X[B+3]=EX(X[B+3]); PIN(X); SBAR(); }while(0)
  #define VRD(i) do{ vlo[i]=vtr(vp_+(((i)>>2)*4096+((i)&3)*1024)); vhi[i]=vtr(vp_+(((i)>>2)*4096+((i)&3)*1024+512)); }while(0)
  #define KRD(G,j) do{ if(G){ kload2(kf,kp0+sl_next,j); SBAR(); } }while(0)
  #define STEP(C0,C1,P0,P1,t,GK,GV,GL) do{ SBAR(); \
    const lds_cptr vp_=vp0+sl_prev; \
    VRD(0); SBAR(); float sacc=(P0[0]+P0[1]); \
    GAPA(C0=__builtin_amdgcn_mfma_f32_32x32x16_bf16(kf[0],qr[0],negm,0,0,0), P0[2],P0[3],P0[4],P0[5],     pw0[0]=PKW(P0,0), pw0[1]=PKW(P0,2), pw0); \
    VRD(4); SBAR(); GAPA(C1=__builtin_amdgcn_mfma_f32_32x32x16_bf16(kf[1],qr[0],negm,0,0,0), P0[6],P0[7],P0[8],P0[9],     pw0[2]=PKW(P0,4), pw0[3]=PKW(P0,6), pw0); \
    VRD(1); SBAR(); GAPA(C0=__builtin_amdgcn_mfma_f32_32x32x16_bf16(kf[2],qr[1],C0,0,0,0),   P0[10],P0[11],P0[12],P0[13], pw1[0]=PKW(P0,8), pw1[1]=PKW(P0,10), pw1); \
    VRD(5); SBAR(); GAPA(C1=__builtin_amdgcn_mfma_f32_32x32x16_bf16(kf[3],qr[1],C1,0,0,0),   P0[14],P0[15],P1[0],P1[1],   pw1[2]=PKW(P0,12),pw1[3]=PKW(P0,14), pw1); \
    VRD(2); SBAR(); GAPA(C0=__builtin_amdgcn_mfma_f32_32x32x16_bf16(kf[4],qr[2],C0,0,0,0),   P1[2],P1[3],P1[4],P1[5],     pw2[0]=PKW(P1,0), pw2[1]=PKW(P1,2), pw2); \
    VRD(6); SBAR(); GAPA(C1=__builtin_amdgcn_mfma_f32_32x32x16_bf16(kf[5],qr[2],C1,0,0,0),   P1[6],P1[7],P1[8],P1[9],     pw2[2]=PKW(P1,4), pw2[3]=PKW(P1,6), pw2); \
    VRD(3); SBAR(); GAPA(C0=__builtin_amdgcn_mfma_f32_32x32x16_bf16(kf[6],qr[3],C0,0,0,0),   P1[10],P1[11],P1[12],P1[13], pw3[0]=PKW(P1,8), pw3[1]=PKW(P1,10), pw3); \
    VRD(7); SBAR(); GAPA(C1=__builtin_amdgcn_mfma_f32_32x32x16_bf16(kf[7],qr[3],C1,0,0,0),   P1[14],P1[15],0.f,0.f,       pw3[2]=PKW(P1,12),pw3[3]=PKW(P1,14), pw3); \
    l_reg+=sacc; \
    if(GK){DMA_K((t)+3,sl_cur);} if(GV){DMA_V((t)+1,sl_next);} \
    CMASK(C0,C1,t); \
    { float a=MX3(C0[0],C0[1],C1[0]),b=MX3(C0[2],C0[3],C1[1]); a=MX3(a,C1[2],C1[3]); \
      _Pragma("unroll") for(int r=4;r<16;r+=4){a=MX3(a,C0[r],C0[r+1]);b=MX3(b,C0[r+2],C0[r+3]);a=MX3(a,C1[r],C1[r+1]);b=MX3(b,C1[r+2],C1[r+3]);} \
      float rm=__builtin_fmaxf(a,b); { auto rr=__builtin_amdgcn_permlane32_swap(__float_as_uint(rm),__float_as_uint(rm),false,false); rm=__builtin_fmaxf(__uint_as_float(rr[0]),__uint_as_float(rr[1])); } \
      resc=false; \
      if(__builtin_expect(__any(rm>(float)THRL),0)){ const float dl=__builtin_fmaxf(rm,0.f); mhat+=dl; \
        _Pragma("unroll") for(int r=0;r<16;++r){C0[r]-=dl;C1[r]-=dl;} \
        _Pragma("unroll") for(int r=0;r<16;++r)negm[r]=-mhat; asm volatile("":"+v"(negm)); \
        const float f=__builtin_amdgcn_exp2f(-dl); l_reg*=f; if(hi==0)wsf[r32]=f; resc=true; } } \
    SBAR(); \
    GAPB(o[0]=__builtin_amdgcn_mfma_f32_32x32x16_bf16(PAF(0),VFR(0),o[0],0,0,0), C0,0); \
    GAPB(o[1]=__builtin_amdgcn_mfma_f32_32x32x16_bf16(PAF(0),VFR(4),o[1],0,0,0), C0,4); \
    KRD(GL,0); GAPB(o[0]=__builtin_amdgcn_mfma_f32_32x32x16_bf16(PAF(1),VFR(1),o[0],0,0,0), C0,8); \
    KRD(GL,1); GAPB(o[1]=__builtin_amdgcn_mfma_f32_32x32x16_bf16(PAF(1),VFR(5),o[1],0,0,0), C0,12); \
    KRD(GL,2); GAPB(o[0]=__builtin_amdgcn_mfma_f32_32x32x16_bf16(PAF(2),VFR(2),o[0],0,0,0), C1,0); \
    KRD(GL,3); GAPB(o[1]=__builtin_amdgcn_mfma_f32_32x32x16_bf16(PAF(2),VFR(6),o[1],0,0,0), C1,4); \
    GAPB(o[0]=__builtin_amdgcn_mfma_f32_32x32x16_bf16(PAF(3),VFR(3),o[0],0,0,0), C1,8); \
    GAPB(o[1]=__builtin_amdgcn_mfma_f32_32x32x16_bf16(PAF(3),VFR(7),o[1],0,0,0), C1,12); \
    }while(0)
  int t=1;
  #undef CMASK
  #define CMASK(P0,P1,t) do{}while(0)
  for(;t+5<NT;t+=2){
    STEP(pB0,pB1,pA0,pA1,t,true,true,true);     WAIT_BAR(2); RESC(); ROT();
    STEP(pA0,pA1,pB0,pB1,t+1,true,true,true);   WAIT_BAR(2); RESC(); ROT();
  }
  #undef CMASK
  #define CMASK(P0,P1,t) do{int jb_=(t)-(NT-4); if(jb_>=0)cmask(P0,P1,jb_,qrel,hi);}while(0)
  #define ENDW(tt) do{ if((tt)+3<NT){WAIT_BAR(2);} else if((tt)+2<NT){WAIT_BAR(1);} else {WAIT_BAR(0);} }while(0)
  for(;t+1<NT;t+=2){
    STEP(pB0,pB1,pA0,pA1,t,(t+3<NT),(t+1<NT),(t+1<NT));       ENDW(t);   RESC(); ROT();
    STEP(pA0,pA1,pB0,pB1,t+1,(t+4<NT),(t+2<NT),(t+2<NT));     ENDW(t+1); RESC(); ROT();
  }
  { float sacc=pA0[0]+pA0[1]; _Pragma("unroll") for(int r=2;r<16;++r)sacc+=pA0[r]; _Pragma("unroll") for(int r=0;r<16;++r)sacc+=pA1[r]; l_reg+=sacc;
    pw0=(u32x4){PKW(pA0,0),PKW(pA0,2),PKW(pA0,4),PKW(pA0,6)};pw1=(u32x4){PKW(pA0,8),PKW(pA0,10),PKW(pA0,12),PKW(pA0,14)};pw2=(u32x4){PKW(pA1,0),PKW(pA1,2),PKW(pA1,4),PKW(pA1,6)};pw3=(u32x4){PKW(pA1,8),PKW(pA1,10),PKW(pA1,12),PKW(pA1,14)};
    SBAR(); pv(o,vb0+sl_prev,PAF(0),PAF(1),PAF(2),PAF(3)); }
  #undef PKW
  #undef PAF
  #undef VFR
  #undef PIN
  #undef MX3
  #undef GAPA
  #undef GAPB
  #undef EX
  #undef VRD
  #undef KRD
  #undef STEP
  #undef ENDW
  int eh=hi,er=r32,el=lane; asm volatile("":"+v"(eh),"+v"(er),"+v"(el));
  {auto rr=__builtin_amdgcn_permlane32_swap(__float_as_uint(l_reg),__float_as_uint(l_reg),false,false);l_reg=__uint_as_float(rr[0])+__uint_as_float(rr[1]);}
  if(eh==0)wsf[32+er]=l_reg;asm volatile("s_waitcnt lgkmcnt(0)":::"memory");
  float* sc=A.SC+(size_t)A.vh*(QB*64)+(size_t)(wid*QBLK)*64;
  if(A.mode==0){
    #pragma unroll
    for(int r=0;r<16;++r){const int orow=crow(r,eh); const float rl=__builtin_amdgcn_rcpf(wsf[32+orow]);
      #pragma unroll
      for(int d0=0;d0<2;++d0)sc[orow*64+d0*32+er]=o[d0][r]*rl;}
  } else {
    const float lam=A.lam;
    float q[16];
    #pragma unroll
    for(int r=0;r<16;++r){const int orow=crow(r,eh); const float rl=__builtin_amdgcn_rcpf(wsf[32+orow]); float qq=0.f;
      #pragma unroll
      for(int d0=0;d0<2;++d0){ const float d=sc[orow*64+d0*32+er]-lam*(o[d0][r]*rl); o[d0][r]=d; qq+=d*d; }
      q[r]=half_sum(qq);}
    if(A.mode==1){
      #pragma unroll
      for(int r=0;r<16;++r){const int orow=crow(r,eh);
        #pragma unroll
        for(int d0=0;d0<2;++d0)sc[orow*64+d0*32+er]=o[d0][r];
        if(er==0)wsf[64+orow]=q[r];}
    } else {
      asm volatile("s_waitcnt lgkmcnt(0)":::"memory");
      float rn[16];
      #pragma unroll
      for(int r=0;r<16;++r)rn[r]=rsqrtf((q[r]+wsf[64+crow(r,eh)])*(1.f/128.f)+1e-5f)*0.8f;
      const float* sc0=A.SC+(size_t)(wid*QBLK)*64;
      bf16*stg=(bf16*)(shm+LDS_OST)+wid*2048;
      bf16*Ow=A.Ow+(long)(wid*QBLK)*OPITCH;
      #pragma unroll
      for(int half=0;half<2;++half){
        const float w0=A.subw[half*64+er],w1=A.subw[half*64+32+er];
        #pragma unroll
        for(int r=0;r<16;++r){const int orow=crow(r,eh);
          const float v0=half==0?sc0[orow*64+er]:o[0][r], v1=half==0?sc0[orow*64+32+er]:o[1][r];
          stg[orow*64+er]=__float2bfloat16(v0*rn[r]*w0); stg[orow*64+32+er]=__float2bfloat16(v1*rn[r]*w1);}
        asm volatile("s_waitcnt lgkmcnt(0)":::"memory");
        #pragma unroll
        for(int i=0;i<4;++i){const int row=i*8+(el>>3),ch=el&7; const u32x4 v=*(const u32x4*)(stg+row*64+ch*8); *(u32x4*)(Ow+(long)row*OPITCH+half*64+ch*8)=v;}
        asm volatile("s_waitcnt lgkmcnt(0)":::"memory");
      }
    }
  }
  asm volatile("s_waitcnt vmcnt(0) lgkmcnt(0)\n\ts_barrier":::"memory");
  #undef DMA_K
  #undef DMA_V
  #undef DMA_K0
  #undef DMA_V0
  #undef CMASK
  #undef START
  #undef RESC
  #undef ROT
}
constexpr int ATTN_LDS_BYTES=LDS_BYTES;
#undef SBAR
#undef WAIT_BAR
}

constexpr int NWAVES = 8;
constexpr int N_PHASES = 9;

constexpr size_t WS_WGU1 = WS_W, WS_WD1 = WS_WGU1 + 11 * MiB, WS_WIN = WS_WD1 + 6 * MiB, WS_WO = WS_WIN + 5 * MiB, WS_WGU2 = WS_WO + 2 * MiB, WS_WD2 = WS_WGU2 + 11 * MiB;
static_assert(WS_WD2 + 6 * MiB <= WS_XR, "weight copies fit below XR");
constexpr size_t WS_SC = 440 * MiB;
static_assert(WS_END <= WS_SC && WS_SC + 256 * (size_t)131072 <= 512 * MiB, "scratch map");
constexpr size_t CTL_ZERO_BYTES = 256 * 1024;
constexpr int CW_TMO = 0, CW_CODE = 1, CW_LAM = 1024, CW_BAR = 4096;

constexpr int RING_OFF = 0, RING_BYTES = 131072;
constexpr int CONVRED_OFF = RING_BYTES;
constexpr int LDSCTL_OFF = RING_BYTES + 512, MISC_OFF = LDSCTL_OFF + 320;
constexpr int LDS_BYTES = 147456;
static_assert(MISC_OFF + 128 <= LDS_BYTES, "LDS map");

#define GAS __attribute__((address_space(1)))
#define LAS __attribute__((address_space(3)))
typedef unsigned short bf16;
typedef unsigned v4u __attribute__((ext_vector_type(4)));
typedef float f32x4 __attribute__((ext_vector_type(4)));
typedef GAS unsigned gu32;
#define RLX_AGENT __ATOMIC_RELAXED, __HIP_MEMORY_SCOPE_AGENT
#define LDS_WAIT() asm volatile("s_waitcnt lgkmcnt(0)" ::: "memory")
#define VM_WAIT() asm volatile("s_waitcnt vmcnt(0)" ::: "memory")
__device__ __forceinline__ unsigned pk2(float lo, float hi) { return (unsigned)f2bf(lo) | ((unsigned)f2bf(hi) << 16); }

#define XB_TMO      128
#define XB_XCNT(j)  (256  + 64 * (j))
#define XB_XSUB(j)  (1280 + 64 * (j))
#define XB_XGEN(j)  (2304 + 64 * (j))
#define XB_TOP      3328
#define XB_TOPGEN   3392
#define XCD_BAR_WORDS 3456
#define XB_SPIN_CAP (1u << 18)

__device__ __forceinline__ unsigned xb_ld(unsigned* p)              { return __hip_atomic_load(p, __ATOMIC_RELAXED, __HIP_MEMORY_SCOPE_AGENT); }
__device__ __forceinline__ unsigned xb_add(unsigned* p, unsigned v) { return __hip_atomic_fetch_add(p, v, __ATOMIC_RELAXED, __HIP_MEMORY_SCOPE_AGENT); }
__device__ __forceinline__ unsigned xb_xcc_id() { return (unsigned)__builtin_amdgcn_s_getreg((3 << 11) | 20) & 0xFu; }
#define XB_SPIN(cond, bar) do { unsigned _sp = 0; while (cond) { __builtin_amdgcn_s_sleep(1); \
    if ((++_sp & 255u) == 0u) { if (xb_ld(&(bar)[XB_TMO])) break; if (_sp > XB_SPIN_CAP) { atomicAdd(&(bar)[XB_TMO], 1u); break; } } } } while (0)

struct XcdBarrier {
    unsigned* bar; unsigned x;
    volatile LAS unsigned* st;
};

__device__ __forceinline__ XcdBarrier xcd_barrier_post(unsigned* bar, volatile LAS unsigned* st) {
    XcdBarrier b; b.bar = bar; b.x = xb_xcc_id(); b.st = st;
    if (threadIdx.x == 0) (void)xb_add(&bar[XB_XCNT(b.x)], 1u);
    return b;
}
__device__ __forceinline__ void xcd_barrier_complete(unsigned* bar, unsigned x, unsigned& nloc, unsigned& nx) {
    const unsigned G = gridDim.x * gridDim.y * gridDim.z;
    unsigned sum, cnt, mine, sp = 0u;
    for (;;) {
        sum = 0u; cnt = 0u; mine = 0u;
#pragma unroll
        for (unsigned j = 0; j < 16; ++j) { const unsigned c = xb_ld(&bar[XB_XCNT(j)]); sum += c; cnt += (c > 0u) ? 1u : 0u; mine = (j == x) ? c : mine; }
        if (sum == G) break;
        __builtin_amdgcn_s_sleep(1);
        if ((++sp & 255u) == 0u) { if (xb_ld(&bar[XB_TMO])) break; if (sp > XB_SPIN_CAP) { atomicAdd(&bar[XB_TMO], 1u); break; } }
    }
    nloc = mine > 0u ? mine : 1u; nx = cnt > 0u ? cnt : 1u;
}

__device__ __forceinline__ void xcd_barrier(const XcdBarrier& b) {
    asm volatile("s_waitcnt vmcnt(0)" ::: "memory");
    __syncthreads();
    if (threadIdx.x == 0) {
        unsigned* bar = b.bar;
        __builtin_amdgcn_s_waitcnt(0);
        unsigned nloc = b.st[0], nx = b.st[1];
        if (nloc == 0u) { xcd_barrier_complete(bar, b.x, nloc, nx); b.st[0] = nloc; b.st[1] = nx; }
        const unsigned old = xb_add(&bar[XB_XSUB(b.x)], 1u);
        const unsigned gen = old / nloc;
        if (old + 1u == (gen + 1u) * nloc) {
            __builtin_amdgcn_fence(__ATOMIC_RELEASE, "agent");
            asm volatile("s_waitcnt vmcnt(0)" ::: "memory");
            const unsigned og = xb_add(&bar[XB_TOP], 1u);
            const unsigned tg = og / nx;
            if (og + 1u == (tg + 1u) * nx) xb_add(&bar[XB_TOPGEN], 1u);
            else XB_SPIN(xb_ld(&bar[XB_TOPGEN]) == tg, bar);
            __builtin_amdgcn_fence(__ATOMIC_ACQUIRE, "agent");
            xb_add(&bar[XB_XGEN(b.x)], 1u);
            asm volatile("s_waitcnt vmcnt(0)" ::: "memory");
        } else {
            XB_SPIN(xb_ld(&bar[XB_XGEN(b.x)]) == gen, bar);
            __builtin_amdgcn_fence(__ATOMIC_ACQUIRE, "agent");
            asm volatile("s_waitcnt vmcnt(0)" ::: "memory");
        }
    }
    __syncthreads();
}


__device__ __forceinline__ void p0_transpose_item(const float* W, int K, int N, const float* gain, bf16* WT, int dst_row0, LAS float* scr, int kb, int nb, int lane) {
    const int k0 = 64 * kb, n0 = 32 * nb;
#pragma unroll 8
    for (int i = 0; i < 32; ++i) { const int kk = 2 * i + (lane >> 5); const float g = gain ? gain[k0 + kk] : 1.0f; scr[kk * 33 + (lane & 31)] = W[(size_t)(k0 + kk) * N + n0 + (lane & 31)] * g; }
    LDS_WAIT(); asm volatile("" ::: "memory");
    const int c = lane & 7;
#pragma unroll
    for (int j = 0; j < 4; ++j) { const int n = (lane >> 3) + 8 * j; const LAS float* s = scr + (8 * c) * 33 + n;
        v4u o; o.x = pk2(s[0 * 33], s[1 * 33]); o.y = pk2(s[2 * 33], s[3 * 33]); o.z = pk2(s[4 * 33], s[5 * 33]); o.w = pk2(s[6 * 33], s[7 * 33]);
        *(GAS v4u*)(WT + (size_t)(dst_row0 + n) * K + k0 + 8 * c) = o; }
    LDS_WAIT(); asm volatile("" ::: "memory");
}
__device__ __forceinline__ int map_gu(int n, int up) { return 256 * (n >> 7) + 128 * up + (n & 127); }
__device__ __forceinline__ int map_in(int c) {
    if (c < 1024) { const int base = c & 512, cc = c & 511, s = cc >> 6, half = (cc >> 5) & 1, d = cc & 31; return base + 256 * (s >> 2) + 128 * half + 32 * (s & 3) + d; }
    if (c < 1536) return c;
    const int j = (c - 1536) & 511, g = (c - 1536) >> 9; return 1536 + 256 * (j >> 7) + 128 * g + (j & 127);
}

struct Ptrs {
    const float *x, *meta, *f1n, *f1g, *f1u, *f1d, *mixn, *win, *lq1, *lk1, *lq2, *lk2, *subw, *cw, *cb, *clg, *clb, *wout, *f2n, *f2g, *f2u, *f2d, *fng;
    float* out; unsigned char* ws;
};

__device__ __forceinline__ void p0_prologue(const Ptrs& P, LAS unsigned char* lds, int vcu, int G, int wave, int lane, int tid) {
    unsigned char* ws = P.ws;
    LAS float* scr = (LAS float*)(lds + RING_OFF + wave * 16384);
    const int gw = vcu * NWAVES + wave, NGW = G * NWAVES;
    constexpr int I_GU = (D / 64) * (DFF / 32), I_DN = (DFF / 64) * (D / 32), I_IN = (D / 64) * (DIN / 32), I_O = (D / 64) * (D / 32);
    constexpr int NITEMS = 4 * I_GU + 2 * I_DN + I_IN + I_O;
    for (int it = gw; it < NITEMS; it += NGW) {
        int r = it;
        if (r < 2 * I_GU) { const int up = r >= I_GU; r -= up * I_GU; const int nb = r % (DFF / 32), kb = r / (DFF / 32);
            p0_transpose_item(up ? P.f1u : P.f1g, D, DFF, P.f1n, (bf16*)(ws + WS_WGU1), map_gu(32 * nb, up), scr, kb, nb, lane); continue; } r -= 2 * I_GU;
        if (r < 2 * I_GU) { const int up = r >= I_GU; r -= up * I_GU; const int nb = r % (DFF / 32), kb = r / (DFF / 32);
            p0_transpose_item(up ? P.f2u : P.f2g, D, DFF, P.f2n, (bf16*)(ws + WS_WGU2), map_gu(32 * nb, up), scr, kb, nb, lane); continue; } r -= 2 * I_GU;
        if (r < I_DN) { const int nb = r % (D / 32), kb = r / (D / 32); p0_transpose_item(P.f1d, DFF, D, nullptr, (bf16*)(ws + WS_WD1), 32 * nb, scr, kb, nb, lane); continue; } r -= I_DN;
        if (r < I_DN) { const int nb = r % (D / 32), kb = r / (D / 32); p0_transpose_item(P.f2d, DFF, D, nullptr, (bf16*)(ws + WS_WD2), 32 * nb, scr, kb, nb, lane); continue; } r -= I_DN;
        if (r < I_IN) { const int nb = r % (DIN / 32), kb = r / (DIN / 32); p0_transpose_item(P.win, D, DIN, P.mixn, (bf16*)(ws + WS_WIN), map_in(32 * nb), scr, kb, nb, lane); continue; } r -= I_IN;
        { const int nb = r % (D / 32), kb = r / (D / 32); p0_transpose_item(P.wout, D, D, nullptr, (bf16*)(ws + WS_WO), 32 * nb, scr, kb, nb, lane); }
    }
    bf16* XB = (bf16*)(ws + WS_XB); float* XR = (float*)(ws + WS_XR); float* ss = (float*)(ws + WS_SS);
    for (int m = gw; m < RALL; m += NGW) {
        const float* src = m < M ? P.x + (size_t)m * D : P.meta + (size_t)(m - M) * D;
        const GAS f32x4* xr = (const GAS f32x4*)src + lane;
        f32x4 v[4]; float s = 0.f;
#pragma unroll
        for (int j = 0; j < 4; ++j) { v[j] = xr[64 * j]; s += (v[j].x * v[j].x + v[j].y * v[j].y) + (v[j].z * v[j].z + v[j].w * v[j].w); }
        s = wave_sum(s);
        GAS unsigned long long* o8 = (GAS unsigned long long*)(XB + (size_t)m * D) + lane;
#pragma unroll
        for (int j = 0; j < 4; ++j) o8[64 * j] = (unsigned long long)pk2(v[j].x, v[j].y) | ((unsigned long long)pk2(v[j].z, v[j].w) << 32);
        if (m >= M) {
#pragma unroll
            for (int j = 0; j < 4; ++j) ((GAS f32x4*)(XR + (size_t)m * D) + lane)[64 * j] = v[j];
        }
        if (lane == 0) ss[m] = s;
    }
    const int gt = vcu * NWAVES * 64 + tid, NGT = G * NWAVES * 64;
    for (int i = gt; i < 3 * MP; i += NGT) ss[MP + i] = 0.f;
    float2* rope = (float2*)(ws + WS_ROPE);
    for (int idx = gt; idx < LSEQ * 32; idx += NGT) {
        const int pos = idx >> 5, i = idx & 31;
        const double inv = exp2(-(double)i * (13.287712379549449 / 32.0));
        double sn, cs; nv::sincos_d((double)pos * inv, sn, cs);
        rope[idx] = make_float2((float)cs, (float)sn);
    }
    if (gt == 0) {
        float a = 0.f, b = 0.f;
        for (int i = 0; i < HD; ++i) { a += P.lq1[i] * P.lk1[i]; b += P.lq2[i] * P.lk2[i]; }
        ((float*)(ws + WS_CTL))[CW_LAM] = expf(a) - expf(b) + LAMBDA_INIT;
    }
}

template <int P, int PEND> struct ConvIn {
    static __device__ __forceinline__ void run(float (&y)[64], const float (&w)[CW], const bf16* Zc, int b, int t0) {
        const int tt = t0 - (CW - 1) + P;
        const int row = tt >= 0 ? b * S + tt : (tt >= -NMETA ? M + NMETA + tt : -1);
        const float z = row >= 0 ? bf2f(Zc[(size_t)row * 512]) : 0.f;
#pragma unroll
        for (int j = 0; j < CW; ++j) { constexpr int dummy = 0; (void)dummy; const int t = P - j; if (t >= 0 && t < 64) y[t] = fmaf(w[j], z, y[t]); }
        ConvIn<P + 1, PEND>::run(y, w, Zc, b, t0);
    }
};
template <int PEND> struct ConvIn<PEND, PEND> { static __device__ __forceinline__ void run(float (&)[64], const float (&)[CW], const bf16*, int, int) {} };
__device__ __forceinline__ void conv_chunk(int chunk, const Ptrs& P, LAS unsigned char* lds, int tid, int wave, int lane) {
    const bf16* Z = (const bf16*)(P.ws + WS_Z); bf16* AC = (bf16*)(P.ws + WS_AC);
    LAS float* tile = (LAS float*)(lds + RING_OFF);
    LAS float* red = (LAS float*)(lds + CONVRED_OFF);
    const int c = tid, m0 = chunk * 64, b = m0 >> 13, t0 = m0 & 8191;
    float w[CW];
#pragma unroll
    for (int j = 0; j < CW; ++j) w[j] = P.cw[j * DC + c];
    float y[64]; const float bias = P.cb[c];
#pragma unroll
    for (int t = 0; t < 64; ++t) y[t] = bias;
    ConvIn<0, 64 + CW - 1>::run(y, w, Z + c, b, t0);
#pragma unroll
    for (int t = 0; t < 64; ++t) tile[t * 512 + c] = y[t];
    LDS_WAIT(); __syncthreads();
#pragma unroll
    for (int i = 0; i < 8; ++i) {
        const int t = wave * 8 + i; float v[8]; float s = 0.f;
#pragma unroll
        for (int k = 0; k < 8; ++k) { v[k] = tile[t * 512 + k * 64 + lane]; s += v[k]; }
        const float mu = wave_sum(s) * (1.f / DC); float q = 0.f;
#pragma unroll
        for (int k = 0; k < 8; ++k) { const float d = v[k] - mu; q += d * d; }
        const float rstd = rsqrtf(wave_sum(q) * (1.f / DC) + EPS);
        if (lane == 0) { red[2 * t] = mu; red[2 * t + 1] = rstd; }
    }
    LDS_WAIT(); __syncthreads();
    const float g = P.clg[c], be = P.clb[c];
#pragma unroll
    for (int t = 0; t < 64; ++t) {
        const float v = (y[t] - red[2 * t]) * red[2 * t + 1] * g + be;
        AC[(size_t)(m0 + t) * 1024 + 512 + c] = f2bf(v * pg8::fast_sigmoid(v));
    }
    LDS_WAIT(); __syncthreads();
}

struct Args { const float* in[23]; float* out; unsigned char* ws; int ph_lo, ph_hi, li, pad; };
__global__ void __launch_bounds__(NWAVES * 64, 2) mega_fwd(Args args) {
    extern __shared__ __attribute__((aligned(16))) unsigned char lds_raw[];
    LAS unsigned char* lds = (LAS unsigned char*)lds_raw;
    volatile LAS unsigned* MISC = (volatile LAS unsigned*)(lds + MISC_OFF);
#define PHASE_TID() int tid_ = threadIdx.x; asm volatile("" : "+v"(tid_)); const int tid = tid_, lane = tid & 63, wave = __builtin_amdgcn_readfirstlane(tid >> 6); (void)lane; (void)wave
    const int G = gridDim.x, bx = blockIdx.x, vcu = (G % 8 == 0) ? (bx % 8) * (G / 8) + bx / 8 : bx;
    Ptrs P;
    P.x = args.in[0]; P.meta = args.in[1]; P.f1n = args.in[2]; P.f1g = args.in[3]; P.f1u = args.in[4]; P.f1d = args.in[5]; P.mixn = args.in[6]; P.win = args.in[7];
    P.lq1 = args.in[8]; P.lk1 = args.in[9]; P.lq2 = args.in[10]; P.lk2 = args.in[11]; P.subw = args.in[12]; P.cw = args.in[13]; P.cb = args.in[14]; P.clg = args.in[15]; P.clb = args.in[16];
    P.wout = args.in[17]; P.f2n = args.in[18]; P.f2g = args.in[19]; P.f2u = args.in[20]; P.f2d = args.in[21]; P.fng = args.in[22]; P.out = args.out; P.ws = args.ws;
    unsigned char* ws = args.ws;
    gu32* ctl = (gu32*)(ws + WS_CTL);
    { PHASE_TID(); for (int u = tid; u < (LDS_BYTES - LDSCTL_OFF) / 4; u += NWAVES * 64) ((LAS unsigned*)(lds + LDSCTL_OFF))[u] = 0u; }
    __syncthreads();
    const int lo = args.ph_lo, hi = args.ph_hi;
    XcdBarrier bar; bar.bar = (unsigned*)(ctl + CW_BAR) + args.li * XCD_BAR_WORDS; bar.x = 0; bar.st = nullptr;
    if (hi - lo > 1) bar = xcd_barrier_post((unsigned*)(ctl + CW_BAR) + args.li * XCD_BAR_WORDS, MISC + 8);
#ifndef BUILD_MASK
#define BUILD_MASK 0x1FF
#endif
#define IN(k) ((((BUILD_MASK) >> (k)) & 1) && lo <= (k) && (k) < hi)
#define BOTH(k) (IN(k) && IN((k) + 1))
#define GRID_BAR() xcd_barrier(bar)
    float* ss = (float*)(ws + WS_SS);
    bf16* XB = (bf16*)(ws + WS_XB); float* XR = (float*)(ws + WS_XR); bf16* ACT = (bf16*)(ws + WS_BIG);
    bf16* Qb = (bf16*)(ws + WS_Q); bf16* Kb = (bf16*)(ws + WS_K); bf16* Vb = (bf16*)(ws + WS_V); bf16* Zb = (bf16*)(ws + WS_Z); bf16* AC = (bf16*)(ws + WS_AC);

    if (IN(0)) { { PHASE_TID(); p0_prologue(P, lds, vcu, G, wave, lane, tid); } if (BOTH(0)) GRID_BAR(); }

    if (IN(1)) {
        pg8::Gemm g{XB, (const bf16*)(ws + WS_WGU1), M, 2 * DFF, D}; pg8::StaticOrder So; So.init(M, 2 * DFF, G, bx);
        pg8::EpiGU E{ACT, DFF, ss};
        pg8::gemm_phase<pg8::EpiGU, pg8::StaticOrder, PG8_ALIGN, PG8_SP2>(lds + RING_OFF, g, So, E);
        if (BOTH(1)) GRID_BAR();
    }
    if (IN(2)) {
        pg8::Gemm g{ACT, (const bf16*)(ws + WS_WD1), M, D, DFF}; pg8::StaticOrder So; So.init(M, D, G, bx);
        pg8::EpiRes E{P.x, XR, XB, ss + MP, 0.5f, D};
        pg8::gemm_phase<pg8::EpiRes, pg8::StaticOrder, PG8_ALIGN, PG8_SP2>(lds + RING_OFF, g, So, E);
        if (BOTH(2)) GRID_BAR();
    }
    if (IN(3)) {
        if (bx == 0) { PHASE_TID();
            for (int i = tid; i < 48 * 512 / 8; i += NWAVES * 64) { ((GAS v4u*)(Kb + (size_t)(M + NMETA) * 512))[i] = (v4u){0u, 0u, 0u, 0u}; ((GAS v4u*)(Vb + (size_t)(M + NMETA) * 512))[i] = (v4u){0u, 0u, 0u, 0u}; }
        }
        pg8::Gemm g{XB, (const bf16*)(ws + WS_WIN), M, DIN, D}; pg8::StaticOrder So; So.init(M, DIN, G, bx);
        pg8::EpiIn E{Qb, Kb, Vb, Zb, ss + MP, (const float*)(ws + WS_ROPE), C2};
        pg8::gemm_phase<pg8::EpiIn, pg8::StaticOrder, PG8_ALIGN, PG8_SP2>(lds + RING_OFF, g, So, E);
        if (BOTH(3)) GRID_BAR();
    }
    if (IN(4)) {
        static_assert(attn_body::ATTN_LDS_BYTES <= RING_BYTES, "attention LDS fits the ring region");
        const float lam = ((const float*)(ws + WS_CTL))[CW_LAM];
        float* SC = (float*)(ws + WS_SC) + (size_t)bx * (2 * 256 * 64);
#ifndef NO_ATTN
        for (int vu = vcu; vu < 256; vu += G) {
            const int bh = vu >> 4, b = bh >> 2, h = bh & 3, s16 = vu & 15;
            for (int i = 0; i < 2; ++i) {
                const int qb = i == 0 ? s16 : 31 - s16;
                for (int pass = 0; pass < 4; ++pass) {
                    const int sh = pass >> 1, vh = pass & 1, s = 2 * h + sh;
                    attn_body::PassArgs A;
                    A.Qw = (const attn_body::bf16*)Qb + ((size_t)b * S + 256 * qb) * 512 + s * 64;
                    A.Kreal = (const attn_body::bf16*)Kb + ((size_t)b * S) * 512 + s * 64; A.Kmeta = (const attn_body::bf16*)Kb + (size_t)M * 512 + s * 64;
                    A.Vreal = (const attn_body::bf16*)Vb + ((size_t)b * S) * 512 + h * 128 + vh * 64; A.Vmeta = (const attn_body::bf16*)Vb + (size_t)M * 512 + h * 128 + vh * 64;
                    A.SC = SC; A.Ow = (attn_body::bf16*)AC + ((size_t)b * S + 256 * qb) * 1024 + h * 128; A.subw = P.subw; A.lam = lam;
                    A.qb = qb; A.vh = vh; A.mode = sh == 0 ? 0 : (vh == 0 ? 1 : 2);
                    attn_body::attn_pass<8>(A, (char*)lds_raw + RING_OFF);
                }
            }
        }
#endif
#ifndef NO_CONV
        { PHASE_TID(); for (int ch = vcu; ch < M / 64; ch += G) conv_chunk(ch, P, lds, tid, wave, lane); }
#endif
        if (BOTH(4)) GRID_BAR();
    }
    if (IN(5)) {
        pg8::Gemm g{AC, (const bf16*)(ws + WS_WO), M, D, D}; pg8::StaticOrder So; So.init(M, D, G, bx);
        pg8::EpiRes E{XR, XR, XB, ss + 2 * MP, 1.0f, D};
        pg8::gemm_phase<pg8::EpiRes, pg8::StaticOrder, PG8_ALIGN, PG8_SP2>(lds + RING_OFF, g, So, E);
        if (BOTH(5)) GRID_BAR();
    }
    if (IN(6)) {
        pg8::Gemm g{XB, (const bf16*)(ws + WS_WGU2), M, 2 * DFF, D}; pg8::StaticOrder So; So.init(M, 2 * DFF, G, bx);
        pg8::EpiGU E{ACT, DFF, ss + 2 * MP};
        pg8::gemm_phase<pg8::EpiGU, pg8::StaticOrder, PG8_ALIGN, PG8_SP2>(lds + RING_OFF, g, So, E);
        if (BOTH(6)) GRID_BAR();
    }
    if (IN(7)) {
        pg8::Gemm g{ACT, (const bf16*)(ws + WS_WD2), M, D, DFF}; pg8::StaticOrder So; So.init(M, D, G, bx);
        pg8::EpiRes E{XR, P.out, nullptr, ss + 3 * MP, 0.5f, D};
        pg8::gemm_phase<pg8::EpiRes, pg8::StaticOrder, PG8_ALIGN, PG8_SP2>(lds + RING_OFF, g, So, E);
        if (BOTH(7)) GRID_BAR();
    }
    if (IN(8)) {
        PHASE_TID(); const int gw = vcu * NWAVES + wave, NGW = G * NWAVES; const float* ss4 = ss + 3 * MP;
        f32x4 gv[4];
#pragma unroll
        for (int j = 0; j < 4; ++j) gv[j] = ((const GAS f32x4*)P.fng + lane)[64 * j];
        for (int m = gw; m < M; m += NGW) {
            const float rs = rsqrtf(ss4[m] * (1.f / D) + EPS);
            GAS f32x4* o = (GAS f32x4*)(P.out + (size_t)m * D) + lane;
#pragma unroll
            for (int j = 0; j < 4; ++j) { f32x4 v = o[64 * j]; v = v * gv[j] * rs; o[64 * j] = v; }
        }
    }
#undef IN
#undef BOTH
#undef GRID_BAR
}

#ifndef FUSED_MASK
#define FUSED_MASK 0x1FF
#endif
#ifndef META_NAIVE
#define META_NAIVE 1
#endif
extern "C" void kernel_launch(void* const* d_in, const int* in_sizes, int n_in, void* d_out, int out_size, void* d_ws, size_t ws_size, hipStream_t stream) {
    (void)in_sizes; (void)n_in; (void)out_size;
    static int grid = 0;
    if (grid == 0) {
        if (ws_size < 512 * MiB) { fprintf(stderr, "kernel_launch: workspace %zu < 512 MiB; nothing launched\n", ws_size); grid = -1; return; }
        int dev = 0, cus = 0, per_cu = 0;
        if (hipGetDevice(&dev) != hipSuccess || hipDeviceGetAttribute(&cus, hipDeviceAttributeMultiprocessorCount, dev) != hipSuccess) { grid = -1; return; }
        if (hipFuncSetAttribute((const void*)mega_fwd, hipFuncAttributeMaxDynamicSharedMemorySize, LDS_BYTES) != hipSuccess) { fprintf(stderr, "kernel_launch: hipFuncSetAttribute failed\n"); grid = -1; return; }
        if (hipOccupancyMaxActiveBlocksPerMultiprocessor(&per_cu, (const void*)mega_fwd, NWAVES * 64, LDS_BYTES) != hipSuccess || per_cu < 1) fprintf(stderr, "kernel_launch: occupancy query reports %d\n", per_cu);
        (void)hipGetLastError();
        grid = cus;
    }
    if (grid < 0) return;
    const float* const* in = (const float* const*)d_in;
    unsigned char* ws = (unsigned char*)d_ws; float* out = (float*)d_out;
    float* lamp = (float*)(ws + WS_CTL) + CW_LAM; float2* rope = (float2*)(ws + WS_ROPE);
    float* ss1 = (float*)(ws + WS_SS); float* ss2 = ss1 + MP; float* ss3 = ss2 + MP; float* ss4 = ss3 + MP;
    float* XR = (float*)(ws + WS_XR); bf16_t* XB = (bf16_t*)(ws + WS_XB); bf16_t* ACT = (bf16_t*)(ws + WS_BIG);
    bf16_t* Q = (bf16_t*)(ws + WS_Q); bf16_t* Kb = (bf16_t*)(ws + WS_K); bf16_t* Vb = (bf16_t*)(ws + WS_V); bf16_t* Z = (bf16_t*)(ws + WS_Z); bf16_t* AC = (bf16_t*)(ws + WS_AC);
    (void)hipMemsetAsync(ws + WS_CTL, 0, CTL_ZERO_BYTES, stream);
    Args a{};
    for (int i = 0; i < 23; ++i) a.in[i] = in[i];
    a.out = out; a.ws = ws;
    const int rt_all = (RALL + 63) / 64, rt_m = M / 64;
    int li = 0;
    for (int ph = 0; ph < N_PHASES;) {
        if ((FUSED_MASK >> ph) & 1) {
            int hi = ph + 1;
            if (!META_NAIVE) while (hi < N_PHASES && ((FUSED_MASK >> hi) & 1)) ++hi;
            else while (hi < N_PHASES && ((FUSED_MASK >> hi) & 1) && !(hi >= 2 && hi <= 4)) ++hi;
            a.ph_lo = ph; a.ph_hi = hi; a.li = li++;
            hipLaunchKernelGGL(mega_fwd, dim3(grid), dim3(NWAVES * 64), LDS_BYTES, stream, a);
            if (META_NAIVE) for (int p = ph; p < hi; ++p) {
                if (p == 1) nv::k_gemm_gu<<<dim3(DFF / 64, 1), 256, 0, stream>>>(XB, in[3], in[4], in[2], ss1, ACT, RALL, M);
                if (p == 2) { nv::k_gemm_res<<<dim3(D / 64, 1), 256, 0, stream>>>(ACT, DFF, in[5], in[0], in[1], 0.5f, XR, XB, RALL, M); nv::k_rowss<<<4, 256, 0, stream>>>(XR, ss2, RALL, M); }
                if (p == 3) nv::k_gemm_in<<<dim3(32, 1), 256, 0, stream>>>(XB, in[7], in[6], ss2, rope, Q, Kb, Vb, Z, RALL, M);
            }
            ph = hi; continue;
        }
        switch (ph) {
        case 0: nv::k_prep_rows<<<(RALL + 3) / 4, 256, 0, stream>>>(in[0], in[1], XB, XR, ss1); nv::k_prep_misc<<<(LSEQ * 32 + 255) / 256, 256, 0, stream>>>(rope, lamp, in[8], in[9], in[10], in[11]); break;
        case 1: nv::k_gemm_gu<<<dim3(DFF / 64, rt_all), 256, 0, stream>>>(XB, in[3], in[4], in[2], ss1, ACT, RALL, 0); break;
        case 2: nv::k_gemm_res<<<dim3(D / 64, rt_all), 256, 0, stream>>>(ACT, DFF, in[5], in[0], in[1], 0.5f, XR, XB, RALL, 0); nv::k_rowss<<<(RALL + 3) / 4, 256, 0, stream>>>(XR, ss2, RALL, 0); break;
        case 3: nv::k_gemm_in<<<dim3(32, rt_all), 256, 0, stream>>>(XB, in[7], in[6], ss2, rope, Q, Kb, Vb, Z, RALL, 0); break;
        case 4: nv::k_attn<<<dim3(S / 64, NH, NB), 256, 0, stream>>>(Q, Kb, Vb, in[12], lamp, AC); nv::k_conv<<<M, 256, 0, stream>>>(Z, in[13], in[14], in[15], in[16], AC); break;
        case 5: nv::k_gemm_res<<<dim3(D / 64, rt_m), 256, 0, stream>>>(AC, D, in[17], XR, XR, 1.0f, XR, XB, M, 0); nv::k_rowss<<<M / 4, 256, 0, stream>>>(XR, ss3, M, 0); break;
        case 6: nv::k_gemm_gu<<<dim3(DFF / 64, rt_m), 256, 0, stream>>>(XB, in[19], in[20], in[18], ss3, ACT, M, 0); break;
        case 7: nv::k_gemm_res<<<dim3(D / 64, rt_m), 256, 0, stream>>>(ACT, DFF, in[21], XR, XR, 0.5f, out, nullptr, M, 0); nv::k_rowss<<<M / 4, 256, 0, stream>>>(out, ss4, M, 0); break;
        case 8: nv::k_final<<<M / 4, 256, 0, stream>>>(out, ss4, in[22]); break;
        }
        ++ph;
    }
}
```

```cpp
#include <hip/hip_runtime.h>
#include <stdint.h>
#include <math.h>
#include <cstdio>
#include <cstdint>

typedef unsigned short bf16_t;
__device__ __forceinline__ float bf2f(bf16_t v) { return __uint_as_float(((unsigned)v) << 16); }
__device__ __forceinline__ bf16_t f2bf(float f) { unsigned u = __float_as_uint(f); return (bf16_t)((u + 0x7fffu + ((u >> 16) & 1u)) >> 16); }

constexpr int NB = 4, S = 8192, D = 1024, NMETA = 16, LSEQ = S + NMETA;
constexpr int M = NB * S;
constexpr int MP = M + 256;
constexpr int RALL = M + NMETA;
constexpr int DFF = 2816, DIN = 2560, DA = 512, DC = 512, HD = 64, NH = 4, CW = 31;
constexpr float EPS = 1e-5f;
constexpr float C2 = 0.125f * 1.4426950408889634f;
constexpr float LAMBDA_INIT = 0.2f;

constexpr size_t MiB = 1u << 20;
constexpr size_t WS_CTL = 0;
constexpr size_t WS_ROPE = 1 * MiB;
constexpr size_t WS_SS = 4 * MiB;
constexpr size_t WS_W = 6 * MiB;
constexpr size_t WS_XR = 48 * MiB;
constexpr size_t WS_XB = 178 * MiB;
constexpr size_t WS_BIG = 244 * MiB;
constexpr size_t SZ_QKVZ = (size_t)MP * 512 * 2;
constexpr size_t WS_Q = WS_BIG, WS_K = WS_Q + SZ_QKVZ, WS_V = WS_K + SZ_QKVZ, WS_Z = WS_V + SZ_QKVZ, WS_AC = WS_Z + SZ_QKVZ;
constexpr size_t WS_END = WS_AC + (size_t)MP * 1024 * 2;
static_assert(WS_BIG + (size_t)MP * DFF * 2 <= 512 * MiB && WS_END <= 512 * MiB, "ws map");

__device__ __forceinline__ int row_pos(int m) { return m < M ? (NMETA + (m & (S - 1))) : (m - M); }
__device__ __forceinline__ float wave_sum(float v) {
#pragma unroll
    for (int o = 1; o < 64; o <<= 1) v += __shfl_xor(v, o);
    return v;
}

namespace nv {
__global__ void __launch_bounds__(256) k_prep_rows(const float* __restrict__ x, const float* __restrict__ meta, bf16_t* XB, float* XR, float* ss1) {
    const int row = blockIdx.x * 4 + (threadIdx.x >> 6), lane = threadIdx.x & 63;
    if (row >= RALL) return;
    const float* src = row < M ? x + (size_t)row * D : meta + (size_t)(row - M) * D;
    float s = 0.f;
    for (int j = 0; j < 4; ++j) {
        const int c = j * 256 + lane * 4;
        const float4 v = *(const float4*)(src + c);
        s += v.x * v.x + v.y * v.y + v.z * v.z + v.w * v.w;
        bf16_t* o = XB + (size_t)row * D + c;
        o[0] = f2bf(v.x); o[1] = f2bf(v.y); o[2] = f2bf(v.z); o[3] = f2bf(v.w);
        if (row >= M) *(float4*)(XR + (size_t)row * D + c) = v;
    }
    s = wave_sum(s);
    if (lane == 0) ss1[row] = s;
}
__device__ __forceinline__ void sincos_d(double a, double& sn, double& cs) {
    const double TWO_OVER_PI = 0.63661977236758134308, PIO2_HI = 1.57079632679489655800e+00, PIO2_LO = 6.12323399573676603587e-17;
    const double kq = rint(a * TWO_OVER_PI);
    double y = fma(-kq, PIO2_HI, a); y = fma(-kq, PIO2_LO, y);
    const double y2 = y * y;
    double sp = -1.0 / 1307674368000.0;
    sp = fma(sp, y2, 1.0 / 6227020800.0);
    sp = fma(sp, y2, -1.0 / 39916800.0);
    sp = fma(sp, y2, 1.0 / 362880.0);
    sp = fma(sp, y2, -1.0 / 5040.0);
    sp = fma(sp, y2, 1.0 / 120.0);
    sp = fma(sp, y2, -1.0 / 6.0);
    const double sy = fma(sp * y2, y, y);
    double cp = 1.0 / 20922789888000.0;
    cp = fma(cp, y2, -1.0 / 87178291200.0);
    cp = fma(cp, y2, 1.0 / 479001600.0);
    cp = fma(cp, y2, -1.0 / 3628800.0);
    cp = fma(cp, y2, 1.0 / 40320.0);
    cp = fma(cp, y2, -1.0 / 720.0);
    cp = fma(cp, y2, 1.0 / 24.0);
    cp = fma(cp, y2, -0.5);
    const double cy = fma(cp, y2, 1.0);
    const long long q = (long long)kq & 3;
    sn = (q == 0) ? sy : (q == 1) ? cy : (q == 2) ? -sy : -cy;
    cs = (q == 0) ? cy : (q == 1) ? -sy : (q == 2) ? -cy : sy;
}
__global__ void __launch_bounds__(256) k_prep_misc(float2* rope, float* lamp, const float* q1, const float* k1, const float* q2, const float* k2) {
    const int idx = blockIdx.x * 256 + threadIdx.x;
    if (idx < LSEQ * 32) {
        const int pos = idx >> 5, i = idx & 31;
        const double inv = exp2(-(double)i * (13.287712379549449 / 32.0));
        double sn, cs; sincos_d((double)pos * inv, sn, cs);
        rope[idx] = make_float2((float)cs, (float)sn);
    }
    if (idx == 0) {
        float a = 0.f, b = 0.f;
        for (int i = 0; i < HD; ++i) { a += q1[i] * k1[i]; b += q2[i] * k2[i]; }
        lamp[0] = expf(a) - expf(b) + LAMBDA_INIT;
    }
}
__global__ void __launch_bounds__(256) k_rowss(const float* __restrict__ X, float* ss, int rows, int mbase) {
    const int row = mbase + blockIdx.x * 4 + (threadIdx.x >> 6), lane = threadIdx.x & 63;
    if (row >= rows) return;
    float s = 0.f;
    for (int j = 0; j < 4; ++j) { const float4 v = *(const float4*)(X + (size_t)row * D + j * 256 + lane * 4); s += v.x * v.x + v.y * v.y + v.z * v.z + v.w * v.w; }
    s = wave_sum(s);
    if (lane == 0) ss[row] = s;
}
__global__ void __launch_bounds__(256) k_final(float* out, const float* __restrict__ ss, const float* __restrict__ g) {
    const int row = blockIdx.x * 4 + (threadIdx.x >> 6), lane = threadIdx.x & 63;
    if (row >= M) return;
    const float rs = rsqrtf(ss[row] * (1.f / D) + EPS);
    for (int j = 0; j < 4; ++j) {
        const int c = j * 256 + lane * 4;
        float4 v = *(float4*)(out + (size_t)row * D + c); const float4 gv = *(const float4*)(g + c);
        v.x *= rs * gv.x; v.y *= rs * gv.y; v.z *= rs * gv.z; v.w *= rs * gv.w;
        *(float4*)(out + (size_t)row * D + c) = v;
    }
}

constexpr int TM = 64, TN = 64, TK = 16;
constexpr int SM_CORE = TK * (TM + 4) + 2 * TK * TN;
template <bool TWO>
__device__ __forceinline__ void core(const bf16_t* __restrict__ A, int lda, int rows, int K, const float* __restrict__ W0, const float* __restrict__ W1, int ldw, int na, int nb,
                                     const float* __restrict__ gain, int m0, float (&acc0)[4][4], float (&acc1)[4][4], float* sm) {
    float (*As)[TM + 4] = (float (*)[TM + 4])sm;
    float (*B0)[TN] = (float (*)[TN])(sm + TK * (TM + 4));
    float (*B1)[TN] = (float (*)[TN])(sm + TK * (TM + 4) + TK * TN);
    const int tid = threadIdx.x, tx = tid & 15, ty = tid >> 4;
#pragma unroll
    for (int i = 0; i < 4; ++i)
#pragma unroll
        for (int j = 0; j < 4; ++j) { acc0[i][j] = 0.f; acc1[i][j] = 0.f; }
    for (int k0 = 0; k0 < K; k0 += TK) {
        {
            const int r = tid >> 2, kq = (tid & 3) * 4, m = m0 + r;
            float a0 = 0.f, a1 = 0.f, a2 = 0.f, a3 = 0.f;
            if (m < rows) { const bf16_t* ap = A + (size_t)m * lda + k0 + kq; a0 = bf2f(ap[0]); a1 = bf2f(ap[1]); a2 = bf2f(ap[2]); a3 = bf2f(ap[3]); }
            As[kq + 0][r] = a0; As[kq + 1][r] = a1; As[kq + 2][r] = a2; As[kq + 3][r] = a3;
        }
        {
            const int kk = tid >> 4, nq = (tid & 15) * 4; const float gk = gain ? gain[k0 + kk] : 1.f;
            const float4 w = *(const float4*)(W0 + (size_t)(k0 + kk) * ldw + na + nq);
            B0[kk][nq + 0] = w.x * gk; B0[kk][nq + 1] = w.y * gk; B0[kk][nq + 2] = w.z * gk; B0[kk][nq + 3] = w.w * gk;
            if (TWO) {
                const float4 w1 = *(const float4*)(W1 + (size_t)(k0 + kk) * ldw + nb + nq);
                B1[kk][nq + 0] = w1.x * gk; B1[kk][nq + 1] = w1.y * gk; B1[kk][nq + 2] = w1.z * gk; B1[kk][nq + 3] = w1.w * gk;
            }
        }
        __syncthreads();
#pragma unroll
        for (int kk = 0; kk < TK; ++kk) {
            float a[4], b[4], c[4];
#pragma unroll
            for (int i = 0; i < 4; ++i) a[i] = As[kk][ty * 4 + i];
#pragma unroll
            for (int j = 0; j < 4; ++j) { b[j] = B0[kk][tx * 4 + j]; c[j] = TWO ? B1[kk][tx * 4 + j] : 0.f; }
#pragma unroll
            for (int i = 0; i < 4; ++i)
#pragma unroll
                for (int j = 0; j < 4; ++j) { acc0[i][j] = fmaf(a[i], b[j], acc0[i][j]); if (TWO) acc1[i][j] = fmaf(a[i], c[j], acc1[i][j]); }
        }
        __syncthreads();
    }
}
__device__ __forceinline__ float silu_f(float v) { return v / (1.f + __expf(-v)); }
__device__ __forceinline__ float sigm_f(float v) { return 1.f / (1.f + __expf(-v)); }

__global__ void __launch_bounds__(256) k_gemm_gu(const bf16_t* XB, const float* Wg, const float* Wu, const float* gain, const float* ss, bf16_t* ACT, int rows, int mbase) {
    __shared__ float sm[SM_CORE];
    float a0[4][4], a1[4][4];
    const int m0 = mbase + blockIdx.y * TM, n0 = blockIdx.x * TN;
    core<true>(XB, D, rows, D, Wg, Wu, DFF, n0, n0, gain, m0, a0, a1, sm);
    const int tx = threadIdx.x & 15, ty = threadIdx.x >> 4;
#pragma unroll
    for (int i = 0; i < 4; ++i) {
        const int m = m0 + ty * 4 + i; if (m >= rows) continue;
        const float rs = rsqrtf(ss[m] * (1.f / D) + EPS);
#pragma unroll
        for (int j = 0; j < 4; ++j) ACT[(size_t)m * DFF + n0 + tx * 4 + j] = f2bf(silu_f(a0[i][j] * rs) * (a1[i][j] * rs));
    }
}
__global__ void __launch_bounds__(256) k_gemm_res(const bf16_t* A, int K, const float* W, const float* resid, const float* resid_meta, float alpha, float* outf, bf16_t* outb, int rows, int mbase) {
    __shared__ float sm[SM_CORE];
    float a0[4][4], a1[4][4];
    const int m0 = mbase + blockIdx.y * TM, n0 = blockIdx.x * TN;
    core<false>(A, K, rows, K, W, nullptr, D, n0, 0, nullptr, m0, a0, a1, sm);
    const int tx = threadIdx.x & 15, ty = threadIdx.x >> 4;
#pragma unroll
    for (int i = 0; i < 4; ++i) {
        const int m = m0 + ty * 4 + i; if (m >= rows) continue;
        const float* rp = m < M ? resid + (size_t)m * D : resid_meta + (size_t)(m - M) * D;
#pragma unroll
        for (int j = 0; j < 4; ++j) {
            const int n = n0 + tx * 4 + j; const float v = rp[n] + alpha * a0[i][j];
            outf[(size_t)m * D + n] = v; if (outb) outb[(size_t)m * D + n] = f2bf(v);
        }
    }
}
__global__ void __launch_bounds__(256) k_gemm_in(const bf16_t* XB, const float* Win, const float* gain, const float* ss, const float2* rope, bf16_t* Q, bf16_t* Kb, bf16_t* Vb, bf16_t* Z, int rows, int mbase) {
    __shared__ float sm[SM_CORE];
    __shared__ float T[TM][TN + 1];
    float a0[4][4], a1[4][4];
    const int m0 = mbase + blockIdx.y * TM, lt = blockIdx.x;
    const int tx = threadIdx.x & 15, ty = threadIdx.x >> 4;
    if (lt < 24) core<false>(XB, D, rows, D, Win, nullptr, DIN, lt * 64, 0, gain, m0, a0, a1, sm);
    else core<true>(XB, D, rows, D, Win, Win, DIN, 1536 + (lt - 24) * 64, 2048 + (lt - 24) * 64, gain, m0, a0, a1, sm);
#pragma unroll
    for (int i = 0; i < 4; ++i) {
        const int m = m0 + ty * 4 + i; const float rs = m < rows ? rsqrtf(ss[m] * (1.f / D) + EPS) : 0.f;
#pragma unroll
        for (int j = 0; j < 4; ++j) { a0[i][j] *= rs; a1[i][j] *= rs; }
    }
    if (lt < 16) {
#pragma unroll
        for (int i = 0; i < 4; ++i)
#pragma unroll
            for (int j = 0; j < 4; ++j) T[ty * 4 + i][tx * 4 + j] = a0[i][j];
        __syncthreads();
        const int hs = lt & 7; bf16_t* O = lt < 8 ? Q : Kb; const float sc = lt < 8 ? C2 : 1.f;
        for (int e = threadIdx.x; e < 64 * 32; e += 256) {
            const int r = e >> 5, c = e & 31, m = m0 + r; if (m >= rows) continue;
            const float2 cs = rope[row_pos(m) * 32 + c]; const float x1 = T[r][c], x2 = T[r][c + 32];
            O[(size_t)m * 512 + hs * 64 + c] = f2bf((x1 * cs.x - x2 * cs.y) * sc);
            O[(size_t)m * 512 + hs * 64 + 32 + c] = f2bf((x2 * cs.x + x1 * cs.y) * sc);
        }
    } else {
#pragma unroll
        for (int i = 0; i < 4; ++i) {
            const int m = m0 + ty * 4 + i; if (m >= rows) continue;
#pragma unroll
            for (int j = 0; j < 4; ++j) {
                const int c = (lt & 7) * 64 + tx * 4 + j;
                if (lt < 24) Vb[(size_t)m * 512 + c] = f2bf(a0[i][j]); else Z[(size_t)m * 512 + c] = f2bf(a0[i][j] * sigm_f(a1[i][j]));
            }
        }
    }
}

__global__ void __launch_bounds__(256) k_attn(const bf16_t* __restrict__ Q, const bf16_t* __restrict__ Kb, const bf16_t* __restrict__ Vb, const float* __restrict__ subw, const float* __restrict__ lamp, bf16_t* AC) {
    __shared__ float Ks[64][64];
    __shared__ bf16_t Vs[64][128];
    __shared__ float Ps[64][65];
    const int qt = blockIdx.x, h = blockIdx.y, b = blockIdx.z;
    const int tid = threadIdx.x, r = tid >> 2, j = tid & 3;
    const int t = qt * 64 + r; const size_t mq = (size_t)b * S + t;
    const float lam = lamp[0];
    float o1[32];
#pragma unroll
    for (int c = 0; c < 32; ++c) o1[c] = 0.f;
    for (int sh = 0; sh < 2; ++sh) {
        const int s = 2 * h + sh;
        float q[64];
#pragma unroll
        for (int d = 0; d < 64; ++d) q[d] = bf2f(Q[mq * 512 + s * 64 + d]);
        float m_run = -INFINITY, l_run = 0.f; float o[32];
#pragma unroll
        for (int c = 0; c < 32; ++c) o[c] = 0.f;
        const int ntile = qt + 2;
        for (int kt = 0; kt < ntile; ++kt) {
            __syncthreads();
            for (int e = tid; e < 64 * 64; e += 256) {
                const int key = e >> 6, d = e & 63; const bool valid = kt == 0 ? key < NMETA : true;
                const size_t row = kt == 0 ? (size_t)(M + (key & 15)) : (size_t)b * S + (kt - 1) * 64 + key;
                Ks[key][d] = valid ? bf2f(Kb[row * 512 + s * 64 + d]) : 0.f;
            }
            for (int e = tid; e < 64 * 128; e += 256) {
                const int key = e >> 7, c = e & 127; const bool valid = kt == 0 ? key < NMETA : true;
                const size_t row = kt == 0 ? (size_t)(M + (key & 15)) : (size_t)b * S + (kt - 1) * 64 + key;
                Vs[key][c] = valid ? Vb[row * 512 + h * 128 + c] : (bf16_t)0;
            }
            __syncthreads();
            float sc[16]; float tmax = -INFINITY;
#pragma unroll
            for (int kk = 0; kk < 16; ++kk) {
                const int key = j * 16 + kk; float a = 0.f;
#pragma unroll
                for (int d = 0; d < 64; ++d) a = fmaf(q[d], Ks[key][d], a);
                const bool ok = kt == 0 ? key < NMETA : ((kt - 1) * 64 + key <= t);
                sc[kk] = ok ? a : -INFINITY; tmax = fmaxf(tmax, sc[kk]);
            }
            tmax = fmaxf(tmax, __shfl_xor(tmax, 1)); tmax = fmaxf(tmax, __shfl_xor(tmax, 2));
            const float m_new = fmaxf(m_run, tmax);
            const float alpha = exp2f(m_run - m_new);
            float psum = 0.f;
#pragma unroll
            for (int kk = 0; kk < 16; ++kk) { const float pv = exp2f(sc[kk] - m_new); psum += pv; Ps[r][j * 16 + kk] = pv; }
            psum += __shfl_xor(psum, 1); psum += __shfl_xor(psum, 2);
            l_run = l_run * alpha + psum; m_run = m_new;
            __syncthreads();
#pragma unroll
            for (int c = 0; c < 32; ++c) o[c] *= alpha;
            for (int key = 0; key < 64; ++key) {
                const float pv = Ps[r][key];
#pragma unroll
                for (int c = 0; c < 32; ++c) o[c] = fmaf(pv, bf2f(Vs[key][j * 32 + c]), o[c]);
            }
        }
        const float il = 1.f / l_run;
        if (sh == 0) {
#pragma unroll
            for (int c = 0; c < 32; ++c) o1[c] = o[c] * il;
        } else {
            float ssq = 0.f;
#pragma unroll
            for (int c = 0; c < 32; ++c) { o1[c] = o1[c] - lam * (o[c] * il); ssq += o1[c] * o1[c]; }
            ssq += __shfl_xor(ssq, 1); ssq += __shfl_xor(ssq, 2);
            const float rn = rsqrtf(ssq * (1.f / 128.f) + EPS) * (1.f - LAMBDA_INIT);
#pragma unroll
            for (int c = 0; c < 32; ++c) AC[mq * 1024 + h * 128 + j * 32 + c] = f2bf(o1[c] * rn * subw[j * 32 + c]);
        }
    }
}
__global__ void __launch_bounds__(256) k_conv(const bf16_t* __restrict__ Z, const float* __restrict__ cw, const float* __restrict__ cb, const float* __restrict__ lg, const float* __restrict__ lb, bf16_t* AC) {
    __shared__ float red[8];
    const int m = blockIdx.x, b = m / S, t = m % S, pos = NMETA + t, tid = threadIdx.x;
    float y[2];
#pragma unroll
    for (int u = 0; u < 2; ++u) {
        const int c = tid + u * 256; float a = cb[c];
        for (int j = 0; j < CW; ++j) {
            const int p = pos - (CW - 1) + j; if (p < 0) continue;
            const size_t row = p < NMETA ? (size_t)(M + p) : (size_t)b * S + (p - NMETA);
            a = fmaf(cw[j * DC + c], bf2f(Z[row * 512 + c]), a);
        }
        y[u] = a;
    }
    float s = wave_sum(y[0] + y[1]);
    if ((tid & 63) == 0) red[tid >> 6] = s;
    __syncthreads();
    const float mu = (red[0] + red[1] + red[2] + red[3]) * (1.f / DC);
    const float d0 = y[0] - mu, d1 = y[1] - mu;
    float q = wave_sum(d0 * d0 + d1 * d1);
    if ((tid & 63) == 0) red[4 + (tid >> 6)] = q;
    __syncthreads();
    const float rstd = rsqrtf((red[4] + red[5] + red[6] + red[7]) * (1.f / DC) + EPS);
#pragma unroll
    for (int u = 0; u < 2; ++u) {
        const int c = tid + u * 256; const float v = (u ? d1 : d0) * rstd * lg[c] + lb[c];
        AC[(size_t)m * 1024 + 512 + c] = f2bf(silu_f(v));
    }
}
}


namespace pg8 {
#define PG8_LAS __attribute__((address_space(3)))
typedef unsigned short bf16_t;
typedef short bf16x8 __attribute__((ext_vector_type(8)));
typedef float f32x4 __attribute__((ext_vector_type(4)));
typedef unsigned u32x4 __attribute__((ext_vector_type(4)));
constexpr int BM = 256, BK = 64, HALF = 128, HTB = HALF * BK * 2  , STAGE_BYTES = 8 * HTB, NXCD = 8, WGM = 8;

__host__ __device__ __forceinline__ int lds_byte(int r, int c) { const int st = (r >> 4) * 2 + (c >> 5), rr = r & 15, cc = c & 31, ob = rr * 64 + cc * 2; return st * 1024 + (ob ^ (((ob >> 9) & 1) << 5)); }
__host__ __device__ __forceinline__ void stage_rc(int b, int& R, int& C) { const int st = b / 1024, sb = b % 1024, swz = sb ^ (((sb >> 9) & 1) << 5); R = (st >> 1) * 16 + swz / 64; C = (st & 1) * 32 + (swz % 64) / 2; }
__host__ __device__ __forceinline__ int perm32(int rho) { const int n = rho >> 4, i = rho & 15; return 8 * (i >> 2) + 4 * n + (i & 3); }

struct Unit { int pm, pn; };
struct Gemm { const bf16_t* A; const bf16_t* Bt; int M, N, K; };

struct StaticOrder {
    int nM, nN, nwg, G, c;
    __host__ __device__ void init(int M, int N, int G_, int c_) { nM = M / BM; nN = N / BM; nwg = nM * nN; G = G_; c = c_; }
    __host__ __device__ bool next(int i, Unit& u) const {
        const long L = (long)i * G + c; if (L >= nwg) return false;
        int wgid = (int)L; { const int q = nwg / NXCD, r = nwg % NXCD, xcd = wgid % NXCD, off = wgid / NXCD; wgid = (xcd < r ? xcd * (q + 1) : r * (q + 1) + (xcd - r) * q) + off; }
        const int nig = WGM * nN, gid = wgid / nig, fm = gid * WGM, gsz = (nM - fm) < WGM ? (nM - fm) : WGM;
        u.pm = fm + ((wgid % nig) % gsz); u.pn = (wgid % nig) / gsz; return true;
    }
    __device__ __forceinline__ void a_ready(const Unit&) const {}
    __device__ __forceinline__ void done(const Unit&) const {}
};

__device__ __forceinline__ unsigned cvt_pk_bf16(float lo, float hi) { unsigned r; asm volatile("v_cvt_pk_bf16_f32 %0, %1, %2" : "=v"(r) : "v"(lo), "v"(hi)); return r; }
typedef unsigned u32x2 __attribute__((ext_vector_type(2)));
constexpr float EPI_EPS = 1e-5f, EPI_INVD = 1.0f / 1024.0f, EPI_LOG2E = 1.4426950408889634f;
__device__ __forceinline__ float fast_sigmoid(float v) { return __builtin_amdgcn_rcpf(1.0f + __builtin_amdgcn_exp2f(-EPI_LOG2E * v)); }

struct EpiGU {
    static constexpr bool PERM = true, AFTER_DRAIN = false;
    bf16_t* O; int ldo; const float* ss;
    __device__ __forceinline__ void operator()(const f32x4 (&acc)[2][2][4][2], const Unit& u, int wr, int wc, int fr, int fq) const {
        const int row0 = u.pm * BM + wr * 64 + fr, col0 = u.pn * HALF + wc * 32 + 8 * fq;
#pragma unroll
        for (int ai = 0; ai < 2; ++ai)
#pragma unroll
            for (int m = 0; m < 4; ++m) {
                const int row = row0 + ai * HALF + m * 16; const float rs = rsqrtf(ss[row] * EPI_INVD + EPI_EPS);
                float o[8];
#pragma unroll
                for (int n = 0; n < 2; ++n)
#pragma unroll
                    for (int i = 0; i < 4; ++i) { const float g = acc[ai][0][m][n][i] * rs, up = acc[ai][1][m][n][i] * rs; o[4 * n + i] = g * fast_sigmoid(g) * up; }
                u32x4 w; w.x = cvt_pk_bf16(o[0], o[1]); w.y = cvt_pk_bf16(o[2], o[3]); w.z = cvt_pk_bf16(o[4], o[5]); w.w = cvt_pk_bf16(o[6], o[7]);
                *(u32x4*)(O + (size_t)row * ldo + col0) = w;
            }
    }
};
struct EpiRes {
    static constexpr bool PERM = false, AFTER_DRAIN = false;
    const float* resid; float* outf; bf16_t* outb; float* ss; float alpha; int ldc;
    __device__ __forceinline__ void operator()(const f32x4 (&acc)[2][2][4][2], const Unit& u, int wr, int wc, int fr, int fq) const {
        const int row0 = u.pm * BM + wr * 64 + fr, col0 = u.pn * BM + wc * 32 + 4 * fq;
#pragma unroll
        for (int ai = 0; ai < 2; ++ai)
#pragma unroll
            for (int m = 0; m < 4; ++m) {
                const int row = row0 + ai * HALF + m * 16; const size_t off = (size_t)row * ldc + col0; float q = 0.f;
#pragma unroll
                for (int bj = 0; bj < 2; ++bj)
#pragma unroll
                    for (int n = 0; n < 2; ++n) {
                        const f32x4 rv = *(const f32x4*)(resid + off + bj * HALF + n * 16);
                        const f32x4 v = rv + acc[ai][bj][m][n] * alpha;
                        *(f32x4*)(outf + off + bj * HALF + n * 16) = v;
                        q += (v[0] * v[0] + v[1] * v[1]) + (v[2] * v[2] + v[3] * v[3]);
                        if (outb) { u32x2 w; w.x = cvt_pk_bf16(v[0], v[1]); w.y = cvt_pk_bf16(v[2], v[3]); *(u32x2*)(outb + off + bj * HALF + n * 16) = w; }
                    }
                q += __shfl_xor(q, 16); q += __shfl_xor(q, 32);
                if (fq == 0) atomicAdd(ss + row, q);
                asm volatile("" ::: "memory");
            }
    }
};
struct EpiIn {
    static constexpr bool PERM = true, AFTER_DRAIN = false;
    bf16_t *Q, *K, *V, *Z; const float* ss; const float* rope; float qscale;
    __device__ __forceinline__ void operator()(const f32x4 (&acc)[2][2][4][2], const Unit& u, int wr, int wc, int fr, int fq) const {
        const int row0 = u.pm * BM + wr * 64 + fr, pn = u.pn, j0 = wc * 32 + 8 * fq;
#pragma unroll
        for (int ai = 0; ai < 2; ++ai)
#pragma unroll
            for (int m = 0; m < 4; ++m) {
                const int row = row0 + ai * HALF + m * 16; const float rs = rsqrtf(ss[row] * EPI_INVD + EPI_EPS);
                float x0[8], x1[8];
#pragma unroll
                for (int n = 0; n < 2; ++n)
#pragma unroll
                    for (int i = 0; i < 4; ++i) { x0[4 * n + i] = acc[ai][0][m][n][i] * rs; x1[4 * n + i] = acc[ai][1][m][n][i] * rs; }
                u32x4 w0, w1;
                if (pn < 4) {
                    const int pos = 16 + (row & 8191); const float sc = pn < 2 ? qscale : 1.0f;
                    const f32x4* rp = (const f32x4*)(rope + ((size_t)pos * 32 + 8 * fq) * 2);
                    float o0[8], o1[8];
#pragma unroll
                    for (int p = 0; p < 4; ++p) { const f32x4 cs = rp[p];
                        o0[2 * p] = (x0[2 * p] * cs[0] - x1[2 * p] * cs[1]) * sc; o1[2 * p] = (x1[2 * p] * cs[0] + x0[2 * p] * cs[1]) * sc;
                        o0[2 * p + 1] = (x0[2 * p + 1] * cs[2] - x1[2 * p + 1] * cs[3]) * sc; o1[2 * p + 1] = (x1[2 * p + 1] * cs[2] + x0[2 * p + 1] * cs[3]) * sc; }
                    w0.x = cvt_pk_bf16(o0[0], o0[1]); w0.y = cvt_pk_bf16(o0[2], o0[3]); w0.z = cvt_pk_bf16(o0[4], o0[5]); w0.w = cvt_pk_bf16(o0[6], o0[7]);
                    w1.x = cvt_pk_bf16(o1[0], o1[1]); w1.y = cvt_pk_bf16(o1[2], o1[3]); w1.z = cvt_pk_bf16(o1[4], o1[5]); w1.w = cvt_pk_bf16(o1[6], o1[7]);
                    bf16_t* O = (pn < 2 ? Q : K) + (size_t)row * 512 + ((pn & 1) * 4 + wc) * 64 + 8 * fq;
                    *(u32x4*)O = w0; *(u32x4*)(O + 32) = w1;
                } else if (pn < 6) {
                    w0.x = cvt_pk_bf16(x0[0], x0[1]); w0.y = cvt_pk_bf16(x0[2], x0[3]); w0.z = cvt_pk_bf16(x0[4], x0[5]); w0.w = cvt_pk_bf16(x0[6], x0[7]);
                    w1.x = cvt_pk_bf16(x1[0], x1[1]); w1.y = cvt_pk_bf16(x1[2], x1[3]); w1.z = cvt_pk_bf16(x1[4], x1[5]); w1.w = cvt_pk_bf16(x1[6], x1[7]);
                    bf16_t* O = V + (size_t)row * 512 + (pn - 4) * 256 + j0;
                    *(u32x4*)O = w0; *(u32x4*)(O + HALF) = w1;
                } else {
                    float o[8];
#pragma unroll
                    for (int e = 0; e < 8; ++e) o[e] = x0[e] * fast_sigmoid(x1[e]);
                    w0.x = cvt_pk_bf16(o[0], o[1]); w0.y = cvt_pk_bf16(o[2], o[3]); w0.z = cvt_pk_bf16(o[4], o[5]); w0.w = cvt_pk_bf16(o[6], o[7]);
                    *(u32x4*)(Z + (size_t)row * 512 + (pn - 6) * HALF + j0) = w0;
                }
            }
    }
};

template <class Epi, class Sched, bool ALIGN_EPI = false, bool SP2 = false>
__device__ __forceinline__ void gemm_phase(PG8_LAS unsigned char* lds, const Gemm g, const Sched& S, const Epi& E) {
    int tid_ = threadIdx.x; asm volatile("" : "+v"(tid_));
    const int tid = tid_, wid = __builtin_amdgcn_readfirstlane(tid >> 6), lane = tid & 63, wr = wid >> 2, wc = wid & 3, fr = lane & 15, fq = lane >> 4;
    const int K = g.K, nt = K / BK;
    unsigned voffA[2], voffB[2];
#pragma unroll
    for (int i = 0; i < 2; ++i) { int R, C; stage_rc(tid * 16 + i * 8192, R, C); const int Rb = Epi::PERM ? ((R & ~31) + perm32(R & 31)) : R;
        voffA[i] = (unsigned)(R * K + C) * 2u; voffB[i] = (unsigned)(Rb * K + C) * 2u; }
    const size_t kstep = (size_t)(BK * 2);
    const size_t hstep = (size_t)HALF * K * 2;
    const size_t tstep = 2 * hstep;
    const unsigned ldsw = (unsigned)wid * 1024u;
    const int aoff = lds_byte(wr * 64 + fr, fq * 8), boff = lds_byte(wc * 32 + fr, fq * 8);
#define PG8_SA(b, h) (((b) * 2 + (h)) * HTB)
#define PG8_SB(b, h) ((4 + (b) * 2 + (h)) * HTB)
#define PG8_STAGE(bufoff, gbase, voff) do { _Pragma("unroll") for (int _i = 0; _i < 2; ++_i) \
        __builtin_amdgcn_global_load_lds((const unsigned*)((const char*)(gbase) + (voff)[_i]), (PG8_LAS unsigned*)(lds + (bufoff) + ldsw + _i * 8192), 16, 0, 0); } while (0)
#define PG8_LDA(dst, b, h) do { _Pragma("unroll") for (int m = 0; m < 4; ++m) _Pragma("unroll") for (int k = 0; k < 2; ++k) dst[m][k] = *(const PG8_LAS bf16x8*)(lds + PG8_SA(b, h) + aoff + m * 2048 + k * 1024); } while (0)
#define PG8_LDB(dst, b, h) do { _Pragma("unroll") for (int n = 0; n < 2; ++n) _Pragma("unroll") for (int k = 0; k < 2; ++k) dst[n][k] = *(const PG8_LAS bf16x8*)(lds + PG8_SB(b, h) + boff + n * 2048 + k * 1024); } while (0)
#define PG8_MMA(ai, bj, At, Bt) do { __builtin_amdgcn_s_setprio(1); _Pragma("unroll") for (int m = 0; m < 4; ++m) _Pragma("unroll") for (int n = 0; n < 2; ++n) _Pragma("unroll") for (int k = 0; k < 2; ++k) \
        acc[ai][bj][m][n] = __builtin_amdgcn_mfma_f32_16x16x32_bf16(Bt[n][k], At[m][k], acc[ai][bj][m][n], 0, 0, 0); __builtin_amdgcn_s_setprio(0); } while (0)
#define PG8_WAIT_V(n) asm volatile("s_waitcnt vmcnt(" #n ")" ::: "memory")
#define PG8_WAIT_L(n) asm volatile("s_waitcnt lgkmcnt(" #n ")" ::: "memory")
#define PG8_BAR __builtin_amdgcn_s_barrier()
#define PG8_SCHED __builtin_amdgcn_sched_barrier(0)
    Unit cur, nxt; int ui = 0;
    if (!S.next(0, cur)) return;
    f32x4 acc[2][2][4][2];
#pragma unroll
    for (int a = 0; a < 2; ++a)
#pragma unroll
        for (int b = 0; b < 2; ++b)
#pragma unroll
            for (int m = 0; m < 4; ++m)
#pragma unroll
                for (int n = 0; n < 2; ++n) acc[a][b][m][n] = (f32x4){0.f, 0.f, 0.f, 0.f};
    bf16x8 At[4][2], B0[2][2], B1[2][2];
    const char* cA = (const char*)g.A + (size_t)cur.pm * tstep; const char* cB = (const char*)g.Bt + (size_t)cur.pn * tstep;
    S.a_ready(cur);
    if constexpr (SP2) {
        PG8_STAGE(PG8_SB(0, 0), cB, voffB); PG8_STAGE(PG8_SB(0, 1), cB + hstep, voffB); PG8_STAGE(PG8_SA(0, 0), cA, voffA); PG8_STAGE(PG8_SA(0, 1), cA + hstep, voffA);
        if (wr == 1) PG8_BAR;
        PG8_WAIT_V(2); PG8_BAR;
        PG8_STAGE(PG8_SB(1, 0), cB + kstep, voffB); PG8_STAGE(PG8_SA(1, 0), cA + kstep, voffA); PG8_STAGE(PG8_SB(1, 1), cB + hstep + kstep, voffB);
        PG8_WAIT_V(6); PG8_BAR;
    } else {
        PG8_STAGE(PG8_SB(0, 0), cB, voffB); PG8_STAGE(PG8_SA(0, 0), cA, voffA); PG8_STAGE(PG8_SB(0, 1), cB + hstep, voffB); PG8_STAGE(PG8_SA(0, 1), cA + hstep, voffA);
        if (wr == 1) PG8_BAR;
        PG8_WAIT_V(4); PG8_BAR;
        PG8_STAGE(PG8_SB(1, 0), cB + kstep, voffB); PG8_STAGE(PG8_SA(1, 0), cA + kstep, voffA); PG8_STAGE(PG8_SB(1, 1), cB + hstep + kstep, voffB);
        PG8_WAIT_V(6); PG8_BAR;
    }
    for (;;) {
        const bool has_next = S.next(ui + 1, nxt);
        const char* nA = has_next ? (const char*)g.A + (size_t)nxt.pm * tstep : cA; const char* nB = has_next ? (const char*)g.Bt + (size_t)nxt.pn * tstep : cB;
        for (int t = 0; t < nt; t += 2) {
            const bool last = (t == nt - 2);
            const char* a1 = cA + (size_t)(t + 1) * kstep;
            const char* a2 = last ? nA : cA + (size_t)(t + 2) * kstep; const char* b2 = last ? nB : cB + (size_t)(t + 2) * kstep;
            const char* a3 = a2 + kstep; const char* b3 = b2 + kstep;
            if (last && has_next) S.a_ready(nxt);
            if constexpr (SP2) {
            PG8_LDB(B0, 0, 0); PG8_LDB(B1, 0, 1); PG8_SCHED; PG8_LDA(At, 0, 0); PG8_STAGE(PG8_SA(1, 1), a1 + hstep, voffA);
            PG8_WAIT_V(8); PG8_WAIT_L(0); PG8_BAR; PG8_MMA(0, 0, At, B0); PG8_MMA(0, 1, At, B1); PG8_BAR; PG8_SCHED;
            PG8_LDA(At, 0, 1); PG8_STAGE(PG8_SB(0, 0), b2, voffB); PG8_STAGE(PG8_SB(0, 1), b2 + hstep, voffB); PG8_STAGE(PG8_SA(0, 0), a2, voffA);
            PG8_WAIT_V(8); PG8_WAIT_L(0); PG8_BAR; PG8_MMA(1, 0, At, B0); PG8_MMA(1, 1, At, B1); PG8_BAR; PG8_SCHED;
            PG8_LDB(B0, 1, 0); PG8_LDB(B1, 1, 1); PG8_SCHED; PG8_LDA(At, 1, 0); PG8_STAGE(PG8_SA(0, 1), a2 + hstep, voffA);
            PG8_WAIT_V(8); PG8_WAIT_L(0); PG8_BAR; PG8_MMA(0, 0, At, B0); PG8_MMA(0, 1, At, B1); PG8_BAR; PG8_SCHED;
            PG8_LDA(At, 1, 1); PG8_STAGE(PG8_SB(1, 0), b3, voffB); PG8_STAGE(PG8_SB(1, 1), b3 + hstep, voffB); PG8_STAGE(PG8_SA(1, 0), a3, voffA);
            PG8_WAIT_V(8); PG8_WAIT_L(0); PG8_BAR; PG8_MMA(1, 0, At, B0); PG8_MMA(1, 1, At, B1); PG8_BAR; PG8_SCHED;
            } else {
            PG8_LDB(B0, 0, 0); PG8_SCHED; PG8_LDA(At, 0, 0); PG8_STAGE(PG8_SA(1, 1), a1 + hstep, voffA);
            PG8_WAIT_L(8); PG8_BAR; PG8_WAIT_L(0); PG8_MMA(0, 0, At, B0); PG8_BAR; PG8_SCHED;
            PG8_LDB(B1, 0, 1); PG8_STAGE(PG8_SB(0, 0), b2, voffB);
            PG8_BAR; PG8_WAIT_L(0); PG8_MMA(0, 1, At, B1); PG8_BAR;
            PG8_LDA(At, 0, 1); PG8_STAGE(PG8_SA(0, 0), a2, voffA);
            PG8_BAR; PG8_WAIT_L(0); PG8_MMA(1, 0, At, B0); PG8_BAR; PG8_SCHED;
            PG8_STAGE(PG8_SB(0, 1), b2 + hstep, voffB);
            PG8_WAIT_V(6); PG8_BAR; PG8_MMA(1, 1, At, B1); PG8_BAR;
            PG8_LDB(B0, 1, 0); PG8_SCHED; PG8_LDA(At, 1, 0); PG8_STAGE(PG8_SA(0, 1), a2 + hstep, voffA);
            PG8_WAIT_L(8); PG8_BAR; PG8_WAIT_L(0); PG8_MMA(0, 0, At, B0); PG8_BAR; PG8_SCHED;
            PG8_LDB(B1, 1, 1); PG8_STAGE(PG8_SB(1, 0), b3, voffB);
            PG8_BAR; PG8_WAIT_L(0); PG8_MMA(0, 1, At, B1); PG8_BAR;
            PG8_LDA(At, 1, 1); PG8_STAGE(PG8_SA(1, 0), a3, voffA);
            PG8_BAR; PG8_WAIT_L(0); PG8_MMA(1, 0, At, B0); PG8_BAR; PG8_SCHED;
            PG8_STAGE(PG8_SB(1, 1), b3 + hstep, voffB);
            PG8_WAIT_V(6); PG8_BAR; PG8_MMA(1, 1, At, B1); PG8_BAR;
            }
        }
        if constexpr (ALIGN_EPI) { if (wr == 0) PG8_BAR; }
        if constexpr (!Epi::AFTER_DRAIN) { E(acc, cur, wr, wc, fr, fq); S.done(cur); }
        if (!has_next) break;
#pragma unroll
        for (int a = 0; a < 2; ++a)
#pragma unroll
            for (int b = 0; b < 2; ++b)
#pragma unroll
                for (int m = 0; m < 4; ++m)
#pragma unroll
                    for (int n = 0; n < 2; ++n) acc[a][b][m][n] = (f32x4){0.f, 0.f, 0.f, 0.f};
        cur = nxt; cA = nA; cB = nB; ++ui;
        if constexpr (ALIGN_EPI) { if (wr == 1) PG8_BAR; }
    }
    PG8_WAIT_V(0);
    if constexpr (!ALIGN_EPI) { if (wr == 0) PG8_BAR; }
    PG8_BAR;
    if constexpr (Epi::AFTER_DRAIN) { E.fused(acc, cur, wr, wc, fr, fq, lds, wid, lane); S.done(cur); }
#undef PG8_SA
#undef PG8_SB
#undef PG8_STAGE
#undef PG8_LDA
#undef PG8_LDB
#undef PG8_MMA
#undef PG8_WAIT_V
#undef PG8_WAIT_L
#undef PG8_BAR
#undef PG8_SCHED
}
}

#ifndef PG8_SP2
#define PG8_SP2 true
#endif
#ifndef PG8_ALIGN
#define PG8_ALIGN true
#endif

#include <hip/hip_bf16.h>
namespace attn_body {
using bf16=__hip_bfloat16;
using bf16x8=__attribute__((ext_vector_type(8)))short;
using s16x4=__attribute__((ext_vector_type(4)))short;
using f32x16=__attribute__((ext_vector_type(16)))float;
using u32x4=__attribute__((ext_vector_type(4)))unsigned;
constexpr int PITCH=512;
constexpr int OPITCH=1024;
constexpr int NW=8,QBLK=32,QB=QBLK*NW,KVBLK=64;
__device__ __forceinline__ int crow(int r,int hi){return (r&3)+8*(r>>2)+4*hi;}
#define SBAR() __builtin_amdgcn_sched_barrier(0)
__device__ __forceinline__ void cmask(f32x16&p0,f32x16&p1,int jb,int qrel,int hi){
  const float NEG=-INFINITY; int kb=64*jb+4*hi;
  #pragma unroll
  for(int r=0;r<16;++r){int kv=kb+(r&3)+8*(r>>2); if(kv>qrel)p0[r]=NEG; if(kv+32>qrel)p1[r]=NEG;}
}
__device__ __forceinline__ void metamask(f32x16&p0,f32x16&p1){
  const float NEG=-INFINITY;
  #pragma unroll
  for(int r=0;r<16;++r){ if(r>=8)p0[r]=NEG; p1[r]=NEG; }
}

constexpr int NSLOT=3, SLOTB=8192;
constexpr int LDS_K=0, LDS_V=NSLOT*SLOTB, LDS_WS=2*NSLOT*SLOTB, LDS_OST=LDS_WS+NW*128*4, LDS_BYTES=LDS_OST+NW*4096;
__device__ __forceinline__ void glds16(const void*gsrc,unsigned lds_dst){unsigned keep;
  asm volatile("s_mov_b32 %0, m0\n\ts_mov_b32 m0, %2\n\ts_nop 0\n\tglobal_load_lds_dwordx4 %1, off\n\ts_mov_b32 m0, %0":"=&s"(keep):"v"(gsrc),"s"(lds_dst):"memory");}
__device__ __forceinline__ float max3f(float a,float b,float c){float r;asm("v_max3_f32 %0, %1, %2, %3":"=v"(r):"v"(a),"v"(b),"v"(c));return r;}
__device__ __forceinline__ float max2f(float a,float b){float r;asm("v_max_f32_e32 %0, %1, %2":"=v"(r):"v"(a),"v"(b));return r;}
__device__ __forceinline__ float fadd_s(float a,float b){float r;asm("v_add_f32_e32 %0, %1, %2":"=v"(r):"v"(a),"v"(b));return r;}
__device__ __forceinline__ float fsub_s(float a,float b){float r;asm("v_sub_f32_e32 %0, %1, %2":"=v"(r):"v"(a),"v"(b));return r;}
typedef float f32x2_t __attribute__((ext_vector_type(2))); typedef __bf16 bf16x2_t __attribute__((ext_vector_type(2)));
__device__ __forceinline__ unsigned cvtpk_s(float lo,float hi){f32x2_t v={lo,hi};bf16x2_t b=__builtin_convertvector(v,bf16x2_t);return __builtin_bit_cast(unsigned,b);}
#define WAIT_BAR(N) asm volatile("s_waitcnt vmcnt(" #N ") lgkmcnt(0)\n\ts_barrier":::"memory")

__device__ __forceinline__ void qkt(f32x16&p0,f32x16&p1,const char*Kslot,const bf16x8*qr,const f32x16&negm,int r32,int hi){
  const char*kb=Kslot+hi*1024+r32*16;
  #pragma unroll
  for(int d0=0;d0<4;++d0){
    const bf16x8 b0=*reinterpret_cast<const bf16x8*>(kb+d0*2048);
    const bf16x8 b1=*reinterpret_cast<const bf16x8*>(kb+d0*2048+512);
    if(d0==0){p0=__builtin_amdgcn_mfma_f32_32x32x16_bf16(b0,qr[0],negm,0,0,0);p1=__builtin_amdgcn_mfma_f32_32x32x16_bf16(b1,qr[0],negm,0,0,0);}
    else{p0=__builtin_amdgcn_mfma_f32_32x32x16_bf16(b0,qr[d0],p0,0,0,0);p1=__builtin_amdgcn_mfma_f32_32x32x16_bf16(b1,qr[d0],p1,0,0,0);}}
}
typedef __attribute__((address_space(3))) const char* lds_cptr;
typedef short v4i16_t __attribute__((ext_vector_type(4)));
__device__ __forceinline__ void kload8(bf16x8*kf,lds_cptr kp){
  kf[0]=*(const __attribute__((address_space(3))) bf16x8*)(kp);      kf[1]=*(const __attribute__((address_space(3))) bf16x8*)(kp+512);
  kf[2]=*(const __attribute__((address_space(3))) bf16x8*)(kp+2048); kf[3]=*(const __attribute__((address_space(3))) bf16x8*)(kp+2560);
  kf[4]=*(const __attribute__((address_space(3))) bf16x8*)(kp+4096); kf[5]=*(const __attribute__((address_space(3))) bf16x8*)(kp+4608);
  kf[6]=*(const __attribute__((address_space(3))) bf16x8*)(kp+6144); kf[7]=*(const __attribute__((address_space(3))) bf16x8*)(kp+6656);
}
__device__ __forceinline__ void kload2(bf16x8*kf,lds_cptr kp,int j){ kf[2*j]=*(const __attribute__((address_space(3))) bf16x8*)(kp+j*2048); kf[2*j+1]=*(const __attribute__((address_space(3))) bf16x8*)(kp+j*2048+512); }
__device__ __forceinline__ s16x4 vtr(lds_cptr p){ return __builtin_bit_cast(s16x4,__builtin_amdgcn_ds_read_tr16_b64_v4i16((__attribute__((address_space(3))) v4i16_t*)p)); }
__device__ __forceinline__ float rowmax(const f32x16&p0,const f32x16&p1){
  float a=max3f(p0[0],p0[1],p1[0]),b=max3f(p0[2],p0[3],p1[1]);a=max3f(a,p1[2],p1[3]);
  #pragma unroll
  for(int r=4;r<16;r+=4){a=max3f(a,p0[r],p0[r+1]);b=max3f(b,p0[r+2],p0[r+3]);a=max3f(a,p1[r],p1[r+1]);b=max3f(b,p1[r+2],p1[r+3]);}
  const float m=max2f(a,b);
  auto rr=__builtin_amdgcn_permlane32_swap(__float_as_uint(m),__float_as_uint(m),false,false);
  return max2f(__uint_as_float(rr[0]),__uint_as_float(rr[1]));
}
__device__ __forceinline__ void pv(f32x16*o,int vb,bf16x8 pa0,bf16x8 pa1,bf16x8 pa2,bf16x8 pa3){
  #pragma unroll
  for(int d0=0;d0<2;++d0){s16x4 lo[4],hi[4];
    #pragma unroll
    for(int ks=0;ks<4;++ks){
      asm volatile("ds_read_b64_tr_b16 %0,%1 offset:%c2":"=&v"(lo[ks]):"v"(vb),"i"(d0*4096+ks*1024):"memory");
      asm volatile("ds_read_b64_tr_b16 %0,%1 offset:%c2":"=&v"(hi[ks]):"v"(vb),"i"(d0*4096+ks*1024+512):"memory");}
    asm volatile("s_waitcnt lgkmcnt(0)":::"memory");SBAR();
    #define PK(k) (bf16x8){lo[k][0],lo[k][1],lo[k][2],lo[k][3],hi[k][0],hi[k][1],hi[k][2],hi[k][3]}
    o[d0]=__builtin_amdgcn_mfma_f32_32x32x16_bf16(pa0,PK(0),o[d0],0,0,0);
    o[d0]=__builtin_amdgcn_mfma_f32_32x32x16_bf16(pa1,PK(1),o[d0],0,0,0);
    o[d0]=__builtin_amdgcn_mfma_f32_32x32x16_bf16(pa2,PK(2),o[d0],0,0,0);
    o[d0]=__builtin_amdgcn_mfma_f32_32x32x16_bf16(pa3,PK(3),o[d0],0,0,0);
    #undef PK
  }
}
__device__ __forceinline__ float half_sum(float v){
  v+=__shfl_xor(v,1);v+=__shfl_xor(v,2);v+=__shfl_xor(v,4);v+=__shfl_xor(v,8);v+=__shfl_xor(v,16);return v;}

struct PassArgs {
  const bf16* Qw;
  const bf16* Kreal;
  const bf16* Kmeta;
  const bf16* Vreal;
  const bf16* Vmeta;
  float* SC;
  bf16* Ow;
  const float* subw;
  float lam;
  int qb, vh, mode;
};
template<int THRL> __device__ __forceinline__ void attn_pass(const PassArgs&A,char*shm){
  int tid_=threadIdx.x; asm volatile("":"+v"(tid_));
  const int tid=tid_,lane=tid&63,r32=lane&31,hi=lane>>5; const int wid=__builtin_amdgcn_readfirstlane(tid>>6);
  const int qb=A.qb;
  const bf16*Qw=A.Qw+(long)(wid*QBLK)*PITCH;
  const unsigned lds0=(unsigned)(uintptr_t)shm;
  float*wsf=(float*)(shm+LDS_WS)+wid*128;
  const bf16*ksrc=A.Kreal+(long)lane*PITCH+wid*8-(long)KVBLK*PITCH;
  const bf16*ksrc0=A.Kmeta+(long)lane*PITCH+wid*8;
  const bf16*vsrc=A.Vreal+(long)(16*(wid&3)+(lane>>2))*PITCH+(wid>>2)*32+(lane&3)*8-(long)KVBLK*PITCH;
  const bf16*vsrc0=A.Vmeta+(long)(16*(wid&3)+(lane>>2))*PITCH+(wid>>2)*32+(lane&3)*8;
  const unsigned kdst=lds0+LDS_K+wid*1024, vdst=lds0+LDS_V+wid*1024;
  #define DMA_K(t,slot) glds16(ksrc+(long)(t)*KVBLK*PITCH,(unsigned)__builtin_amdgcn_readfirstlane(kdst+(slot)))
  #define DMA_V(t,slot) glds16(vsrc+(long)(t)*KVBLK*PITCH,(unsigned)__builtin_amdgcn_readfirstlane(vdst+(slot)))
  #define DMA_K0(slot) glds16(ksrc0,(unsigned)__builtin_amdgcn_readfirstlane(kdst+(slot)))
  #define DMA_V0(slot) glds16(vsrc0,(unsigned)__builtin_amdgcn_readfirstlane(vdst+(slot)))
  const int vb0=(int)(lds0+LDS_V)+((lane>>4)&1)*32+(lane&3)*8+(4*hi+((lane&15)>>2))*64;
  const char*Kbase=shm+LDS_K; bf16x8 kf[8];
  const lds_cptr shm3=(lds_cptr)shm; const lds_cptr kp0=shm3+LDS_K+hi*1024+r32*16; const lds_cptr vp0=shm3+LDS_V+((lane>>4)&1)*32+(lane&3)*8+(4*hi+((lane&15)>>2))*64;
  const int NT=4*qb+5;
  DMA_K0(0);DMA_V0(0);DMA_K(1,SLOTB);
  bf16x8 qr[4];
  #pragma unroll
  for(int d0=0;d0<4;++d0)qr[d0]=*reinterpret_cast<const bf16x8*>(&Qw[(long)r32*PITCH+d0*16+hi*8]);
  float mhat=0.f,l_reg=0.f;f32x16 o[2];o[0]=f32x16{};o[1]=f32x16{};f32x16 negm;
  #pragma unroll
  for(int r=0;r<16;++r){float z_;asm volatile("v_mov_b32 %0, 0":"=v"(z_));negm[r]=z_;}
  asm volatile("":"+v"(negm));
  const int qrel=wid*QBLK+r32;
  #define CMASK(P0,P1,t) do{int jb_=(t)-(NT-4); if(jb_>=0)cmask(P0,P1,jb_,qrel,hi);}while(0)
  bool resc=false;
  #define START(P0,P1) do{ const float rm=rowmax(P0,P1); resc=false; \
    { const float dl=rm; mhat=fadd_s(mhat,dl); \
      _Pragma("unroll") for(int r=0;r<16;++r){P0[r]=fsub_s(P0[r],dl);P1[r]=fsub_s(P1[r],dl);} \
      _Pragma("unroll") for(int r=0;r<16;++r)negm[r]=-mhat; asm volatile("":"+v"(negm)); } \
    _Pragma("unroll") for(int r=0;r<16;++r)P0[r]=__builtin_amdgcn_exp2f(P0[r]); }while(0)
  #define RESC() do{ if(resc){ asm volatile("s_waitcnt lgkmcnt(0)":::"memory"); \
      _Pragma("unroll") for(int d_=0;d_<2;++d_) _Pragma("unroll") for(int r=0;r<16;++r)o[d_][r]*=wsf[crow(r,hi)]; } }while(0)
  f32x16 pA0,pA1,pB0,pB1;
  int sl_prev=0,sl_cur=0,sl_next=SLOTB;
  #define ROT() do{sl_prev=sl_cur;sl_cur=sl_next;sl_next=(sl_next==(NSLOT-1)*SLOTB)?0:sl_next+SLOTB;}while(0)
  DMA_K(2,2*SLOTB);
  WAIT_BAR(3);
  qkt(pA0,pA1,Kbase,qr,negm,r32,hi);asm volatile("s_nop 15\n\ts_nop 7":"+v"(pA0),"+v"(pA1));metamask(pA0,pA1);
  START(pA0,pA1);
  _Pragma("unroll") for(int r=0;r<16;++r)pA1[r]=__builtin_amdgcn_exp2f(pA1[r]);
  WAIT_BAR(0);
  DMA_K(3,0);DMA_V(1,SLOTB);
  ROT();
  kload8(kf,kp0+sl_cur);
  WAIT_BAR(2);
  s16x4 vlo[8],vhi[8]; u32x4 pw0,pw1,pw2,pw3;
  #define PKW(P,B) cvtpk_s(P[B],P[B+1])
  #define PAF(k) __builtin_bit_cast(bf16x8,pw##k)
  #define VFR(i) (bf16x8){vlo[i][0],vlo[i][1],vlo[i][2],vlo[i][3],vhi[i][0],vhi[i][1],vhi[i][2],vhi[i][3]}
  #define PIN(x) asm volatile("":"+v"(x))
  #define MX3(a,b,c) __builtin_fmaxf(__builtin_fmaxf((a),(b)),(c))
  #define GAPA(MF,A0,A1,A2,A3,W0,W1,PW) do{ MF; sacc+=A0; sacc+=A1; sacc+=A2; sacc+=A3; PIN(sacc); W0; W1; PIN(PW); SBAR(); }while(0)
  #define EX(v) __builtin_amdgcn_exp2f(v)
  #define GAPB(MF,X,B) do{ MF; X[B]=EX(X[B]); X[B+1]=EX(X[B+1]); X[B+2]=EX(X[B+2]); X[B+3]=EX(X[B+3]); PIN(X); SBAR(); }while(0)
  #define VRD(i) do{ vlo[i]=vtr(vp_+(((i)>>2)*4096+((i)&3)*1024)); vhi[i]=vtr(vp_+(((i)>>2)*4096+((i)&3)*1024+512)); }while(0)
  #define KRD(G,j) do{ if(G){ kload2(kf,kp0+sl_next,j); SBAR(); } }while(0)
  #define STEP(C0,C1,P0,P1,t,GK,GV,GL) do{ SBAR(); \
    const lds_cptr vp_=vp0+sl_prev; \
    VRD(0); SBAR(); float sacc=(P0[0]+P0[1]); \
    GAPA(C0=__builtin_amdgcn_mfma_f32_32x32x16_bf16(kf[0],qr[0],negm,0,0,0), P0[2],P0[3],P0[4],P0[5],     pw0[0]=PKW(P0,0), pw0[1]=PKW(P0,2), pw0); \
    VRD(4); SBAR(); GAPA(C1=__builtin_amdgcn_mfma_f32_32x32x16_bf16(kf[1],qr[0],negm,0,0,0), P0[6],P0[7],P0[8],P0[9],     pw0[2]=PKW(P0,4), pw0[3]=PKW(P0,6), pw0); \
    VRD(1); SBAR(); GAPA(C0=__builtin_amdgcn_mfma_f32_32x32x16_bf16(kf[2],qr[1],C0,0,0,0),   P0[10],P0[11],P0[12],P0[13], pw1[0]=PKW(P0,8), pw1[1]=PKW(P0,10), pw1); \
    VRD(5); SBAR(); GAPA(C1=__builtin_amdgcn_mfma_f32_32x32x16_bf16(kf[3],qr[1],C1,0,0,0),   P0[14],P0[15],P1[0],P1[1],   pw1[2]=PKW(P0,12),pw1[3]=PKW(P0,14), pw1); \
    VRD(2); SBAR(); GAPA(C0=__builtin_amdgcn_mfma_f32_32x32x16_bf16(kf[4],qr[2],C0,0,0,0),   P1[2],P1[3],P1[4],P1[5],     pw2[0]=PKW(P1,0), pw2[1]=PKW(P1,2), pw2); \
    VRD(6); SBAR(); GAPA(C1=__builtin_amdgcn_mfma_f32_32x32x16_bf16(kf[5],qr[2],C1,0,0,0),   P1[6],P1[7],P1[8],P1[9],     pw2[2]=PKW(P1,4), pw2[3]=PKW(P1,6), pw2); \
    VRD(3); SBAR(); GAPA(C0=__builtin_amdgcn_mfma_f32_32x32x16_bf16(kf[6],qr[3],C0,0,0,0),   P1[10],P1[11],P1[12],P1[13], pw3[0]=PKW(P1,8), pw3[1]=PKW(P1,10), pw3); \
    VRD(7); SBAR(); GAPA(C1=__builtin_amdgcn_mfma_f32_32x32x16_bf16(kf[7],qr[3],C1,0,0,0),   P1[14],P1[15],0.f,0.f,       pw3[2]=PKW(P1,12),pw3[3]=PKW(P1,14), pw3); \
    l_reg+=sacc; \
    if(GK){DMA_K((t)+3,sl_cur);} if(GV){DMA_V((t)+1,sl_next);} \
    CMASK(C0,C1,t); \
    { float a=MX3(C0[0],C0[1],C1[0]),b=MX3(C0[2],C0[3],C1[1]); a=MX3(a,C1[2],C1[3]); \
      _Pragma("unroll") for(int r=4;r<16;r+=4){a=MX3(a,C0[r],C0[r+1]);b=MX3(b,C0[r+2],C0[r+3]);a=MX3(a,C1[r],C1[r+1]);b=MX3(b,C1[r+2],C1[r+3]);} \
      float rm=__builtin_fmaxf(a,b); { auto rr=__builtin_amdgcn_permlane32_swap(__float_as_uint(rm),__float_as_uint(rm),false,false); rm=__builtin_fmaxf(__uint_as_float(rr[0]),__uint_as_float(rr[1])); } \
      resc=false; \
      if(__builtin_expect(__any(rm>(float)THRL),0)){ const float dl=__builtin_fmaxf(rm,0.f); mhat+=dl; \
        _Pragma("unroll") for(int r=0;r<16;++r){C0[r]-=dl;C1[r]-=dl;} \
        _Pragma("unroll") for(int r=0;r<16;++r)negm[r]=-mhat; asm volatile("":"+v"(negm)); \
        const float f=__builtin_amdgcn_exp2f(-dl); l_reg*=f; if(hi==0)wsf[r32]=f; resc=true; } } \
    SBAR(); \
    GAPB(o[0]=__builtin_amdgcn_mfma_f32_32x32x16_bf16(PAF(0),VFR(0),o[0],0,0,0), C0,0); \
    GAPB(o[1]=__builtin_amdgcn_mfma_f32_32x32x16_bf16(PAF(0),VFR(4),o[1],0,0,0), C0,4); \
    KRD(GL,0); GAPB(o[0]=__builtin_amdgcn_mfma_f32_32x32x16_bf16(PAF(1),VFR(1),o[0],0,0,0), C0,8); \
    KRD(GL,1); GAPB(o[1]=__builtin_amdgcn_mfma_f32_32x32x16_bf16(PAF(1),VFR(5),o[1],0,0,0), C0,12); \
    KRD(GL,2); GAPB(o[0]=__builtin_amdgcn_mfma_f32_32x32x16_bf16(PAF(2),VFR(2),o[0],0,0,0), C1,0); \
    KRD(GL,3); GAPB(o[1]=__builtin_amdgcn_mfma_f32_32x32x16_bf16(PAF(2),VFR(6),o[1],0,0,0), C1,4); \
    GAPB(o[0]=__builtin_amdgcn_mfma_f32_32x32x16_bf16(PAF(3),VFR(3),o[0],0,0,0), C1,8); \
    GAPB(o[1]=__builtin_amdgcn_mfma_f32_32x32x16_bf16(PAF(3),VFR(7),o[1],0,0,0), C1,12); \
    }while(0)
  int t=1;
  #undef CMASK
  #define CMASK(P0,P1,t) do{}while(0)
  for(;t+5<NT;t+=2){
    STEP(pB0,pB1,pA0,pA1,t,true,true,true);     WAIT_BAR(2); RESC(); ROT();
    STEP(pA0,pA1,pB0,pB1,t+1,true,true,true);   WAIT_BAR(2); RESC(); ROT();
  }
  #undef CMASK
  #define CMASK(P0,P1,t) do{int jb_=(t)-(NT-4); if(jb_>=0)cmask(P0,P1,jb_,qrel,hi);}while(0)
  #define ENDW(tt) do{ if((tt)+3<NT){WAIT_BAR(2);} else if((tt)+2<NT){WAIT_BAR(1);} else {WAIT_BAR(0);} }while(0)
  for(;t+1<NT;t+=2){
    STEP(pB0,pB1,pA0,pA1,t,(t+3<NT),(t+1<NT),(t+1<NT));       ENDW(t);   RESC(); ROT();
    STEP(pA0,pA1,pB0,pB1,t+1,(t+4<NT),(t+2<NT),(t+2<NT));     ENDW(t+1); RESC(); ROT();
  }
  { float sacc=pA0[0]+pA0[1]; _Pragma("unroll") for(int r=2;r<16;++r)sacc+=pA0[r]; _Pragma("unroll") for(int r=0;r<16;++r)sacc+=pA1[r]; l_reg+=sacc;
    pw0=(u32x4){PKW(pA0,0),PKW(pA0,2),PKW(pA0,4),PKW(pA0,6)};pw1=(u32x4){PKW(pA0,8),PKW(pA0,10),PKW(pA0,12),PKW(pA0,14)};pw2=(u32x4){PKW(pA1,0),PKW(pA1,2),PKW(pA1,4),PKW(pA1,6)};pw3=(u32x4){PKW(pA1,8),PKW(pA1,10),PKW(pA1,12),PKW(pA1,14)};
    SBAR(); pv(o,vb0+sl_prev,PAF(0),PAF(1),PAF(2),PAF(3)); }
  #undef PKW
  #undef PAF
  #undef VFR
  #undef PIN
  #undef MX3
  #undef GAPA
  #undef GAPB
  #undef EX
  #undef VRD
  #undef KRD
  #undef STEP
  #undef ENDW
  int eh=hi,er=r32,el=lane; asm volatile("":"+v"(eh),"+v"(er),"+v"(el));
  {auto rr=__builtin_amdgcn_permlane32_swap(__float_as_uint(l_reg),__float_as_uint(l_reg),false,false);l_reg=__uint_as_float(rr[0])+__uint_as_float(rr[1]);}
  if(eh==0)wsf[32+er]=l_reg;asm volatile("s_waitcnt lgkmcnt(0)":::"memory");
  float* sc=A.SC+(size_t)A.vh*(QB*64)+(size_t)(wid*QBLK)*64;
  if(A.mode==0){
    #pragma unroll
    for(int r=0;r<16;++r){const int orow=crow(r,eh); const float rl=__builtin_amdgcn_rcpf(wsf[32+orow]);
      #pragma unroll
      for(int d0=0;d0<2;++d0)sc[orow*64+d0*32+er]=o[d0][r]*rl;}
  } else {
    const float lam=A.lam;
    float q[16];
    #pragma unroll
    for(int r=0;r<16;++r){const int orow=crow(r,eh); const float rl=__builtin_amdgcn_rcpf(wsf[32+orow]); float qq=0.f;
      #pragma unroll
      for(int d0=0;d0<2;++d0){ const float d=sc[orow*64+d0*32+er]-lam*(o[d0][r]*rl); o[d0][r]=d; qq+=d*d; }
      q[r]=half_sum(qq);}
    if(A.mode==1){
      #pragma unroll
      for(int r=0;r<16;++r){const int orow=crow(r,eh);
        #pragma unroll
        for(int d0=0;d0<2;++d0)sc[orow*64+d0*32+er]=o[d0][r];
        if(er==0)wsf[64+orow]=q[r];}
    } else {
      asm volatile("s_waitcnt lgkmcnt(0)":::"memory");
      float rn[16];
      #pragma unroll
      for(int r=0;r<16;++r)rn[r]=rsqrtf((q[r]+wsf[64+crow(r,eh)])*(1.f/128.f)+1e-5f)*0.8f;
      const float* sc0=A.SC+(size_t)(wid*QBLK)*64;
      bf16*stg=(bf16*)(shm+LDS_OST)+wid*2048;
      bf16*Ow=A.Ow+(long)(wid*QBLK)*OPITCH;
      #pragma unroll
      for(int half=0;half<2;++half){
        const float w0=A.subw[half*64+er],w1=A.subw[half*64+32+er];
        #pragma unroll
        for(int r=0;r<16;++r){const int orow=crow(r,eh);
          const float v0=half==0?sc0[orow*64+er]:o[0][r], v1=half==0?sc0[orow*64+32+er]:o[1][r];
          stg[orow*64+er]=__float2bfloat16(v0*rn[r]*w0); stg[orow*64+32+er]=__float2bfloat16(v1*rn[r]*w1);}
        asm volatile("s_waitcnt lgkmcnt(0)":::"memory");
        #pragma unroll
        for(int i=0;i<4;++i){const int row=i*8+(el>>3),ch=el&7; const u32x4 v=*(const u32x4*)(stg+row*64+ch*8); *(u32x4*)(Ow+(long)row*OPITCH+half*64+ch*8)=v;}
        asm volatile("s_waitcnt lgkmcnt(0)":::"memory");
      }
    }
  }
  asm volatile("s_waitcnt vmcnt(0) lgkmcnt(0)\n\ts_barrier":::"memory");
  #undef DMA_K
  #undef DMA_V
  #undef DMA_K0
  #undef DMA_V0
  #undef CMASK
  #undef START
  #undef RESC
  #undef ROT
}
constexpr int ATTN_LDS_BYTES=LDS_BYTES;
#undef SBAR
#undef WAIT_BAR
}

constexpr int NWAVES = 8;
constexpr int N_PHASES = 9;

constexpr size_t WS_WGU1 = WS_W, WS_WD1 = WS_WGU1 + 11 * MiB, WS_WIN = WS_WD1 + 6 * MiB, WS_WO = WS_WIN + 5 * MiB, WS_WGU2 = WS_WO + 2 * MiB, WS_WD2 = WS_WGU2 + 11 * MiB;
static_assert(WS_WD2 + 6 * MiB <= WS_XR, "weight copies fit below XR");
constexpr size_t WS_SC = 440 * MiB;
static_assert(WS_END <= WS_SC && WS_SC + 256 * (size_t)131072 <= 512 * MiB, "scratch map");
constexpr size_t CTL_ZERO_BYTES = 256 * 1024;
constexpr int CW_TMO = 0, CW_CODE = 1, CW_LAM = 1024, CW_BAR = 4096;

constexpr int RING_OFF = 0, RING_BYTES = 131072;
constexpr int CONVRED_OFF = RING_BYTES;
constexpr int LDSCTL_OFF = RING_BYTES + 512, MISC_OFF = LDSCTL_OFF + 320;
constexpr int LDS_BYTES = 147456;
static_assert(MISC_OFF + 128 <= LDS_BYTES, "LDS map");

#define GAS __attribute__((address_space(1)))
#define LAS __attribute__((address_space(3)))
typedef unsigned short bf16;
typedef unsigned v4u __attribute__((ext_vector_type(4)));
typedef float f32x4 __attribute__((ext_vector_type(4)));
typedef GAS unsigned gu32;
#define RLX_AGENT __ATOMIC_RELAXED, __HIP_MEMORY_SCOPE_AGENT
#define LDS_WAIT() asm volatile("s_waitcnt lgkmcnt(0)" ::: "memory")
#define VM_WAIT() asm volatile("s_waitcnt vmcnt(0)" ::: "memory")
__device__ __forceinline__ unsigned pk2(float lo, float hi) { return (unsigned)f2bf(lo) | ((unsigned)f2bf(hi) << 16); }

#define XB_TMO      128
#define XB_XCNT(j)  (256  + 64 * (j))
#define XB_XSUB(j)  (1280 + 64 * (j))
#define XB_XGEN(j)  (2304 + 64 * (j))
#define XB_TOP      3328
#define XB_TOPGEN   3392
#define XCD_BAR_WORDS 3456
#define XB_SPIN_CAP (1u << 18)

__device__ __forceinline__ unsigned xb_ld(unsigned* p)              { return __hip_atomic_load(p, __ATOMIC_RELAXED, __HIP_MEMORY_SCOPE_AGENT); }
__device__ __forceinline__ unsigned xb_add(unsigned* p, unsigned v) { return __hip_atomic_fetch_add(p, v, __ATOMIC_RELAXED, __HIP_MEMORY_SCOPE_AGENT); }
__device__ __forceinline__ unsigned xb_xcc_id() { return (unsigned)__builtin_amdgcn_s_getreg((3 << 11) | 20) & 0xFu; }
#define XB_SPIN(cond, bar) do { unsigned _sp = 0; while (cond) { __builtin_amdgcn_s_sleep(1); \
    if ((++_sp & 255u) == 0u) { if (xb_ld(&(bar)[XB_TMO])) break; if (_sp > XB_SPIN_CAP) { atomicAdd(&(bar)[XB_TMO], 1u); break; } } } } while (0)

struct XcdBarrier {
    unsigned* bar; unsigned x;
    volatile LAS unsigned* st;
};

__device__ __forceinline__ XcdBarrier xcd_barrier_post(unsigned* bar, volatile LAS unsigned* st) {
    XcdBarrier b; b.bar = bar; b.x = xb_xcc_id(); b.st = st;
    if (threadIdx.x == 0) (void)xb_add(&bar[XB_XCNT(b.x)], 1u);
    return b;
}
__device__ __forceinline__ void xcd_barrier_complete(unsigned* bar, unsigned x, unsigned& nloc, unsigned& nx) {
    const unsigned G = gridDim.x * gridDim.y * gridDim.z;
    unsigned sum, cnt, mine, sp = 0u;
    for (;;) {
        sum = 0u; cnt = 0u; mine = 0u;
#pragma unroll
        for (unsigned j = 0; j < 16; ++j) { const unsigned c = xb_ld(&bar[XB_XCNT(j)]); sum += c; cnt += (c > 0u) ? 1u : 0u; mine = (j == x) ? c : mine; }
        if (sum == G) break;
        __builtin_amdgcn_s_sleep(1);
        if ((++sp & 255u) == 0u) { if (xb_ld(&bar[XB_TMO])) break; if (sp > XB_SPIN_CAP) { atomicAdd(&bar[XB_TMO], 1u); break; } }
    }
    nloc = mine > 0u ? mine : 1u; nx = cnt > 0u ? cnt : 1u;
}

__device__ __forceinline__ void xcd_barrier(const XcdBarrier& b) {
    asm volatile("s_waitcnt vmcnt(0)" ::: "memory");
    __syncthreads();
    if (threadIdx.x == 0) {
        unsigned* bar = b.bar;
        __builtin_amdgcn_s_waitcnt(0);
        unsigned nloc = b.st[0], nx = b.st[1];
        if (nloc == 0u) { xcd_barrier_complete(bar, b.x, nloc, nx); b.st[0] = nloc; b.st[1] = nx; }
        const unsigned old = xb_add(&bar[XB_XSUB(b.x)], 1u);
        const unsigned gen = old / nloc;
        if (old + 1u == (gen + 1u) * nloc) {
            __builtin_amdgcn_fence(__ATOMIC_RELEASE, "agent");
            asm volatile("s_waitcnt vmcnt(0)" ::: "memory");
            const unsigned og = xb_add(&bar[XB_TOP], 1u);
            const unsigned tg = og / nx;
            if (og + 1u == (tg + 1u) * nx) xb_add(&bar[XB_TOPGEN], 1u);
            else XB_SPIN(xb_ld(&bar[XB_TOPGEN]) == tg, bar);
            __builtin_amdgcn_fence(__ATOMIC_ACQUIRE, "agent");
            xb_add(&bar[XB_XGEN(b.x)], 1u);
            asm volatile("s_waitcnt vmcnt(0)" ::: "memory");
        } else {
            XB_SPIN(xb_ld(&bar[XB_XGEN(b.x)]) == gen, bar);
            __builtin_amdgcn_fence(__ATOMIC_ACQUIRE, "agent");
            asm volatile("s_waitcnt vmcnt(0)" ::: "memory");
        }
    }
    __syncthreads();
}


__device__ __forceinline__ void p0_transpose_item(const float* W, int K, int N, const float* gain, bf16* WT, int dst_row0, LAS float* scr, int kb, int nb, int lane) {
    const int k0 = 64 * kb, n0 = 32 * nb;
#pragma unroll 8
    for (int i = 0; i < 32; ++i) { const int kk = 2 * i + (lane >> 5); const float g = gain ? gain[k0 + kk] : 1.0f; scr[kk * 33 + (lane & 31)] = W[(size_t)(k0 + kk) * N + n0 + (lane & 31)] * g; }
    LDS_WAIT(); asm volatile("" ::: "memory");
    const int c = lane & 7;
#pragma unroll
    for (int j = 0; j < 4; ++j) { const int n = (lane >> 3) + 8 * j; const LAS float* s = scr + (8 * c) * 33 + n;
        v4u o; o.x = pk2(s[0 * 33], s[1 * 33]); o.y = pk2(s[2 * 33], s[3 * 33]); o.z = pk2(s[4 * 33], s[5 * 33]); o.w = pk2(s[6 * 33], s[7 * 33]);
        *(GAS v4u*)(WT + (size_t)(dst_row0 + n) * K + k0 + 8 * c) = o; }
    LDS_WAIT(); asm volatile("" ::: "memory");
}
__device__ __forceinline__ int map_gu(int n, int up) { return 256 * (n >> 7) + 128 * up + (n & 127); }
__device__ __forceinline__ int map_in(int c) {
    if (c < 1024) { const int base = c & 512, cc = c & 511, s = cc >> 6, half = (cc >> 5) & 1, d = cc & 31; return base + 256 * (s >> 2) + 128 * half + 32 * (s & 3) + d; }
    if (c < 1536) return c;
    const int j = (c - 1536) & 511, g = (c - 1536) >> 9; return 1536 + 256 * (j >> 7) + 128 * g + (j & 127);
}

struct Ptrs {
    const float *x, *meta, *f1n, *f1g, *f1u, *f1d, *mixn, *win, *lq1, *lk1, *lq2, *lk2, *subw, *cw, *cb, *clg, *clb, *wout, *f2n, *f2g, *f2u, *f2d, *fng;
    float* out; unsigned char* ws;
};

__device__ __forceinline__ void p0_prologue(const Ptrs& P, LAS unsigned char* lds, int vcu, int G, int wave, int lane, int tid) {
    unsigned char* ws = P.ws;
    LAS float* scr = (LAS float*)(lds + RING_OFF + wave * 16384);
    const int gw = vcu * NWAVES + wave, NGW = G * NWAVES;
    constexpr int I_GU = (D / 64) * (DFF / 32), I_DN = (DFF / 64) * (D / 32), I_IN = (D / 64) * (DIN / 32), I_O = (D / 64) * (D / 32);
    constexpr int NITEMS = 4 * I_GU + 2 * I_DN + I_IN + I_O;
    for (int it = gw; it < NITEMS; it += NGW) {
        int r = it;
        if (r < 2 * I_GU) { const int up = r >= I_GU; r -= up * I_GU; const int nb = r % (DFF / 32), kb = r / (DFF / 32);
            p0_transpose_item(up ? P.f1u : P.f1g, D, DFF, P.f1n, (bf16*)(ws + WS_WGU1), map_gu(32 * nb, up), scr, kb, nb, lane); continue; } r -= 2 * I_GU;
        if (r < 2 * I_GU) { const int up = r >= I_GU; r -= up * I_GU; const int nb = r % (DFF / 32), kb = r / (DFF / 32);
            p0_transpose_item(up ? P.f2u : P.f2g, D, DFF, P.f2n, (bf16*)(ws + WS_WGU2), map_gu(32 * nb, up), scr, kb, nb, lane); continue; } r -= 2 * I_GU;
        if (r < I_DN) { const int nb = r % (D / 32), kb = r / (D / 32); p0_transpose_item(P.f1d, DFF, D, nullptr, (bf16*)(ws + WS_WD1), 32 * nb, scr, kb, nb, lane); continue; } r -= I_DN;
        if (r < I_DN) { const int nb = r % (D / 32), kb = r / (D / 32); p0_transpose_item(P.f2d, DFF, D, nullptr, (bf16*)(ws + WS_WD2), 32 * nb, scr, kb, nb, lane); continue; } r -= I_DN;
        if (r < I_IN) { const int nb = r % (DIN / 32), kb = r / (DIN / 32); p0_transpose_item(P.win, D, DIN, P.mixn, (bf16*)(ws + WS_WIN), map_in(32 * nb), scr, kb, nb, lane); continue; } r -= I_IN;
        { const int nb = r % (D / 32), kb = r / (D / 32); p0_transpose_item(P.wout, D, D, nullptr, (bf16*)(ws + WS_WO), 32 * nb, scr, kb, nb, lane); }
    }
    bf16* XB = (bf16*)(ws + WS_XB); float* XR = (float*)(ws + WS_XR); float* ss = (float*)(ws + WS_SS);
    for (int m = gw; m < RALL; m += NGW) {
        const float* src = m < M ? P.x + (size_t)m * D : P.meta + (size_t)(m - M) * D;
        const GAS f32x4* xr = (const GAS f32x4*)src + lane;
        f32x4 v[4]; float s = 0.f;
#pragma unroll
        for (int j = 0; j < 4; ++j) { v[j] = xr[64 * j]; s += (v[j].x * v[j].x + v[j].y * v[j].y) + (v[j].z * v[j].z + v[j].w * v[j].w); }
        s = wave_sum(s);
        GAS unsigned long long* o8 = (GAS unsigned long long*)(XB + (size_t)m * D) + lane;
#pragma unroll
        for (int j = 0; j < 4; ++j) o8[64 * j] = (unsigned long long)pk2(v[j].x, v[j].y) | ((unsigned long long)pk2(v[j].z, v[j].w) << 32);
        if (m >= M) {
#pragma unroll
            for (int j = 0; j < 4; ++j) ((GAS f32x4*)(XR + (size_t)m * D) + lane)[64 * j] = v[j];
        }
        if (lane == 0) ss[m] = s;
    }
    const int gt = vcu * NWAVES * 64 + tid, NGT = G * NWAVES * 64;
    for (int i = gt; i < 3 * MP; i += NGT) ss[MP + i] = 0.f;
    float2* rope = (float2*)(ws + WS_ROPE);
    for (int idx = gt; idx < LSEQ * 32; idx += NGT) {
        const int pos = idx >> 5, i = idx & 31;
        const double inv = exp2(-(double)i * (13.287712379549449 / 32.0));
        double sn, cs; nv::sincos_d((double)pos * inv, sn, cs);
        rope[idx] = make_float2((float)cs, (float)sn);
    }
    if (gt == 0) {
        float a = 0.f, b = 0.f;
        for (int i = 0; i < HD; ++i) { a += P.lq1[i] * P.lk1[i]; b += P.lq2[i] * P.lk2[i]; }
        ((float*)(ws + WS_CTL))[CW_LAM] = expf(a) - expf(b) + LAMBDA_INIT;
    }
}

template <int P, int PEND> struct ConvIn {
    static __device__ __forceinline__ void run(float (&y)[64], const float (&w)[CW], const bf16* Zc, int b, int t0) {
        const int tt = t0 - (CW - 1) + P;
        const int row = tt >= 0 ? b * S + tt : (tt >= -NMETA ? M + NMETA + tt : -1);
        const float z = row >= 0 ? bf2f(Zc[(size_t)row * 512]) : 0.f;
#pragma unroll
        for (int j = 0; j < CW; ++j) { constexpr int dummy = 0; (void)dummy; const int t = P - j; if (t >= 0 && t < 64) y[t] = fmaf(w[j], z, y[t]); }
        ConvIn<P + 1, PEND>::run(y, w, Zc, b, t0);
    }
};
template <int PEND> struct ConvIn<PEND, PEND> { static __device__ __forceinline__ void run(float (&)[64], const float (&)[CW], const bf16*, int, int) {} };
__device__ __forceinline__ void conv_chunk(int chunk, const Ptrs& P, LAS unsigned char* lds, int tid, int wave, int lane) {
    const bf16* Z = (const bf16*)(P.ws + WS_Z); bf16* AC = (bf16*)(P.ws + WS_AC);
    LAS float* tile = (LAS float*)(lds + RING_OFF);
    LAS float* red = (LAS float*)(lds + CONVRED_OFF);
    const int c = tid, m0 = chunk * 64, b = m0 >> 13, t0 = m0 & 8191;
    float w[CW];
#pragma unroll
    for (int j = 0; j < CW; ++j) w[j] = P.cw[j * DC + c];
    float y[64]; const float bias = P.cb[c];
#pragma unroll
    for (int t = 0; t < 64; ++t) y[t] = bias;
    ConvIn<0, 64 + CW - 1>::run(y, w, Z + c, b, t0);
#pragma unroll
    for (int t = 0; t < 64; ++t) tile[t * 512 + c] = y[t];
    LDS_WAIT(); __syncthreads();
#pragma unroll
    for (int i = 0; i < 8; ++i) {
        const int t = wave * 8 + i; float v[8]; float s = 0.f;
#pragma unroll
        for (int k = 0; k < 8; ++k) { v[k] = tile[t * 512 + k * 64 + lane]; s += v[k]; }
        const float mu = wave_sum(s) * (1.f / DC); float q = 0.f;
#pragma unroll
        for (int k = 0; k < 8; ++k) { const float d = v[k] - mu; q += d * d; }
        const float rstd = rsqrtf(wave_sum(q) * (1.f / DC) + EPS);
        if (lane == 0) { red[2 * t] = mu; red[2 * t + 1] = rstd; }
    }
    LDS_WAIT(); __syncthreads();
    const float g = P.clg[c], be = P.clb[c];
#pragma unroll
    for (int t = 0; t < 64; ++t) {
        const float v = (y[t] - red[2 * t]) * red[2 * t + 1] * g + be;
        AC[(size_t)(m0 + t) * 1024 + 512 + c] = f2bf(v * pg8::fast_sigmoid(v));
    }
    LDS_WAIT(); __syncthreads();
}


typedef short mbf16x8 __attribute__((ext_vector_type(8)));
template <int MODE  >
__device__ __forceinline__ void meta_task(int task, const bf16* Ameta, int K, const bf16* Bt, const Ptrs& P, LAS unsigned char* lds) {
    int tid_ = threadIdx.x; asm volatile("" : "+v"(tid_));
    const int tid = tid_, lane = tid & 63, wave = __builtin_amdgcn_readfirstlane(tid >> 6);
    const int pn = (task >> 3) + (MODE == 2 ? 2 : 0), j0 = task & 7, r0 = 256 * pn + 16 * j0;
    const int kw = K >> 3, kbeg = wave * kw;
    f32x4 acc0 = {0.f, 0.f, 0.f, 0.f}, acc1 = {0.f, 0.f, 0.f, 0.f};
    const bf16* ap = Ameta + (size_t)(lane & 15) * K + kbeg + 8 * (lane >> 4);
    const bf16* b0p = Bt + (size_t)(r0 + (lane & 15)) * K + kbeg + 8 * (lane >> 4);
    const bf16* b1p = b0p + (size_t)128 * K;
    for (int ks = 0; ks < kw; ks += 32) {
        const mbf16x8 a = *(const mbf16x8*)(ap + ks), b0 = *(const mbf16x8*)(b0p + ks), b1 = *(const mbf16x8*)(b1p + ks);
        acc0 = __builtin_amdgcn_mfma_f32_16x16x32_bf16(a, b0, acc0, 0, 0, 0);
        acc1 = __builtin_amdgcn_mfma_f32_16x16x32_bf16(a, b1, acc1, 0, 0, 0);
    }
    LAS float* red = (LAS float*)(lds + RING_OFF);
    *(LAS f32x4*)(red + (wave * 64 + lane) * 8) = acc0; *(LAS f32x4*)(red + (wave * 64 + lane) * 8 + 4) = acc1;
    LDS_WAIT(); __syncthreads();
    if (tid < 256) {
        const int l2 = tid >> 2, reg = tid & 3; float v0 = 0.f, v1 = 0.f;
#pragma unroll
        for (int w = 0; w < 8; ++w) { v0 += red[(w * 64 + l2) * 8 + reg]; v1 += red[(w * 64 + l2) * 8 + 4 + reg]; }
        const int row = (l2 >> 4) * 4 + reg, col = l2 & 15, jj = 16 * j0 + col;
        unsigned char* ws = P.ws; const float* ss = (const float*)(ws + WS_SS);
        if (MODE == 0) {
            const float rs = rsqrtf(ss[M + row] * (1.f / D) + EPS), g = v0 * rs, up = v1 * rs;
            ((bf16*)(ws + WS_BIG))[(size_t)(M + row) * DFF + 128 * pn + jj] = f2bf(g * pg8::fast_sigmoid(g) * up);
        } else if (MODE == 1) {
            float* XR = (float*)(ws + WS_XR); bf16* XB = (bf16*)(ws + WS_XB);
            const int n0 = r0 + col, n1 = n0 + 128;
            const float o0 = P.meta[row * D + n0] + 0.5f * v0, o1 = P.meta[row * D + n1] + 0.5f * v1;
            XR[(size_t)(M + row) * D + n0] = o0; XR[(size_t)(M + row) * D + n1] = o1;
            XB[(size_t)(M + row) * D + n0] = f2bf(o0); XB[(size_t)(M + row) * D + n1] = f2bf(o1);
            float q = o0 * o0 + o1 * o1;
            q += __shfl_xor(q, 4); q += __shfl_xor(q, 8); q += __shfl_xor(q, 16); q += __shfl_xor(q, 32);
            if (lane < 4) atomicAdd((float*)(ws + WS_SS) + MP + M + row, q);
        } else {
            const float rs = rsqrtf(ss[MP + M + row] * (1.f / D) + EPS), x0 = v0 * rs, x1 = v1 * rs;
            if (pn < 4) {
                const int sh = (pn & 1) * 4 + (jj >> 5), d = jj & 31; const float2 cs = ((const float2*)(ws + WS_ROPE))[row * 32 + d];
                bf16* Kb = (bf16*)(ws + WS_K) + (size_t)(M + row) * 512 + sh * 64 + d;
                Kb[0] = f2bf(x0 * cs.x - x1 * cs.y); Kb[32] = f2bf(x1 * cs.x + x0 * cs.y);
            } else if (pn < 6) {
                bf16* Vb = (bf16*)(ws + WS_V) + (size_t)(M + row) * 512 + (pn - 4) * 256 + jj;
                Vb[0] = f2bf(x0); Vb[128] = f2bf(x1);
            } else {
                ((bf16*)(ws + WS_Z))[(size_t)(M + row) * 512 + (pn - 6) * 128 + jj] = f2bf(x0 * pg8::fast_sigmoid(x1));
            }
        }
    }
    LDS_WAIT(); __syncthreads();
}

struct Args { const float* in[23]; float* out; unsigned char* ws; int ph_lo, ph_hi, li, pad; };
__global__ void __launch_bounds__(NWAVES * 64, 2) mega_fwd(Args args) {
    extern __shared__ __attribute__((aligned(16))) unsigned char lds_raw[];
    LAS unsigned char* lds = (LAS unsigned char*)lds_raw;
    volatile LAS unsigned* MISC = (volatile LAS unsigned*)(lds + MISC_OFF);
#define PHASE_TID() int tid_ = threadIdx.x; asm volatile("" : "+v"(tid_)); const int tid = tid_, lane = tid & 63, wave = __builtin_amdgcn_readfirstlane(tid >> 6); (void)lane; (void)wave
    const int G = gridDim.x, bx = blockIdx.x, vcu = (G % 8 == 0) ? (bx % 8) * (G / 8) + bx / 8 : bx;
    Ptrs P;
    P.x = args.in[0]; P.meta = args.in[1]; P.f1n = args.in[2]; P.f1g = args.in[3]; P.f1u = args.in[4]; P.f1d = args.in[5]; P.mixn = args.in[6]; P.win = args.in[7];
    P.lq1 = args.in[8]; P.lk1 = args.in[9]; P.lq2 = args.in[10]; P.lk2 = args.in[11]; P.subw = args.in[12]; P.cw = args.in[13]; P.cb = args.in[14]; P.clg = args.in[15]; P.clb = args.in[16];
    P.wout = args.in[17]; P.f2n = args.in[18]; P.f2g = args.in[19]; P.f2u = args.in[20]; P.f2d = args.in[21]; P.fng = args.in[22]; P.out = args.out; P.ws = args.ws;
    unsigned char* ws = args.ws;
    gu32* ctl = (gu32*)(ws + WS_CTL);
    { PHASE_TID(); for (int u = tid; u < (LDS_BYTES - LDSCTL_OFF) / 4; u += NWAVES * 64) ((LAS unsigned*)(lds + LDSCTL_OFF))[u] = 0u; }
    __syncthreads();
    const int lo = args.ph_lo, hi = args.ph_hi;
    XcdBarrier bar; bar.bar = (unsigned*)(ctl + CW_BAR) + args.li * XCD_BAR_WORDS; bar.x = 0; bar.st = nullptr;
    if (hi - lo > 1) bar = xcd_barrier_post((unsigned*)(ctl + CW_BAR) + args.li * XCD_BAR_WORDS, MISC + 8);
#ifndef BUILD_MASK
#define BUILD_MASK 0x1FF
#endif
#define IN(k) ((((BUILD_MASK) >> (k)) & 1) && lo <= (k) && (k) < hi)
#define BOTH(k) (IN(k) && IN((k) + 1))
#define GRID_BAR() xcd_barrier(bar)
    float* ss = (float*)(ws + WS_SS);
    bf16* XB = (bf16*)(ws + WS_XB); float* XR = (float*)(ws + WS_XR); bf16* ACT = (bf16*)(ws + WS_BIG);
    bf16* Qb = (bf16*)(ws + WS_Q); bf16* Kb = (bf16*)(ws + WS_K); bf16* Vb = (bf16*)(ws + WS_V); bf16* Zb = (bf16*)(ws + WS_Z); bf16* AC = (bf16*)(ws + WS_AC);

    if (IN(0)) { { PHASE_TID(); p0_prologue(P, lds, vcu, G, wave, lane, tid); } if (BOTH(0)) GRID_BAR(); }

    if (IN(1)) {
        for (int task = bx; task < 22 * 8; task += G) meta_task<0>(task, XB + (size_t)M * D, D, (const bf16*)(ws + WS_WGU1), P, lds);
        pg8::Gemm g{XB, (const bf16*)(ws + WS_WGU1), M, 2 * DFF, D}; pg8::StaticOrder So; So.init(M, 2 * DFF, G, bx);
        pg8::EpiGU E{ACT, DFF, ss};
        pg8::gemm_phase<pg8::EpiGU, pg8::StaticOrder, PG8_ALIGN, PG8_SP2>(lds + RING_OFF, g, So, E);
        if (BOTH(1)) GRID_BAR();
    }
    if (IN(2)) {
        for (int task = bx; task < 4 * 8; task += G) meta_task<1>(task, ACT + (size_t)M * DFF, DFF, (const bf16*)(ws + WS_WD1), P, lds);
        pg8::Gemm g{ACT, (const bf16*)(ws + WS_WD1), M, D, DFF}; pg8::StaticOrder So; So.init(M, D, G, bx);
        pg8::EpiRes E{P.x, XR, XB, ss + MP, 0.5f, D};
        pg8::gemm_phase<pg8::EpiRes, pg8::StaticOrder, PG8_ALIGN, PG8_SP2>(lds + RING_OFF, g, So, E);
        if (BOTH(2)) GRID_BAR();
    }
    if (IN(3)) {
        if (bx == 0) { PHASE_TID();
            for (int i = tid; i < 48 * 512 / 8; i += NWAVES * 64) { ((GAS v4u*)(Kb + (size_t)(M + NMETA) * 512))[i] = (v4u){0u, 0u, 0u, 0u}; ((GAS v4u*)(Vb + (size_t)(M + NMETA) * 512))[i] = (v4u){0u, 0u, 0u, 0u}; }
        }
        for (int task = G - 1 - bx; task < 8 * 8; task += G) meta_task<2>(task, XB + (size_t)M * D, D, (const bf16*)(ws + WS_WIN), P, lds);
        pg8::Gemm g{XB, (const bf16*)(ws + WS_WIN), M, DIN, D}; pg8::StaticOrder So; So.init(M, DIN, G, bx);
        pg8::EpiIn E{Qb, Kb, Vb, Zb, ss + MP, (const float*)(ws + WS_ROPE), C2};
        pg8::gemm_phase<pg8::EpiIn, pg8::StaticOrder, PG8_ALIGN, PG8_SP2>(lds + RING_OFF, g, So, E);
        if (BOTH(3)) GRID_BAR();
    }
    if (IN(4)) {
        static_assert(attn_body::ATTN_LDS_BYTES <= RING_BYTES, "attention LDS fits the ring region");
        const float lam = ((const float*)(ws + WS_CTL))[CW_LAM];
        float* SC = (float*)(ws + WS_SC) + (size_t)bx * (2 * 256 * 64);
#ifndef NO_ATTN
        for (int vu = vcu; vu < 256; vu += G) {
            const int bh = vu >> 4, b = bh >> 2, h = bh & 3, s16 = vu & 15;
            for (int i = 0; i < 2; ++i) {
                const int qb = i == 0 ? s16 : 31 - s16;
                for (int pass = 0; pass < 4; ++pass) {
                    const int sh = pass >> 1, vh = pass & 1, s = 2 * h + sh;
                    attn_body::PassArgs A;
                    A.Qw = (const attn_body::bf16*)Qb + ((size_t)b * S + 256 * qb) * 512 + s * 64;
                    A.Kreal = (const attn_body::bf16*)Kb + ((size_t)b * S) * 512 + s * 64; A.Kmeta = (const attn_body::bf16*)Kb + (size_t)M * 512 + s * 64;
                    A.Vreal = (const attn_body::bf16*)Vb + ((size_t)b * S) * 512 + h * 128 + vh * 64; A.Vmeta = (const attn_body::bf16*)Vb + (size_t)M * 512 + h * 128 + vh * 64;
                    A.SC = SC; A.Ow = (attn_body::bf16*)AC + ((size_t)b * S + 256 * qb) * 1024 + h * 128; A.subw = P.subw; A.lam = lam;
                    A.qb = qb; A.vh = vh; A.mode = sh == 0 ? 0 : (vh == 0 ? 1 : 2);
                    attn_body::attn_pass<8>(A, (char*)lds_raw + RING_OFF);
                }
            }
        }
#endif
#ifndef NO_CONV
        { PHASE_TID(); for (int ch = vcu; ch < M / 64; ch += G) conv_chunk(ch, P, lds, tid, wave, lane); }
#endif
        if (BOTH(4)) GRID_BAR();
    }
    if (IN(5)) {
        pg8::Gemm g{AC, (const bf16*)(ws + WS_WO), M, D, D}; pg8::StaticOrder So; So.init(M, D, G, bx);
        pg8::EpiRes E{XR, XR, XB, ss + 2 * MP, 1.0f, D};
        pg8::gemm_phase<pg8::EpiRes, pg8::StaticOrder, PG8_ALIGN, PG8_SP2>(lds + RING_OFF, g, So, E);
        if (BOTH(5)) GRID_BAR();
    }
    if (IN(6)) {
        pg8::Gemm g{XB, (const bf16*)(ws + WS_WGU2), M, 2 * DFF, D}; pg8::StaticOrder So; So.init(M, 2 * DFF, G, bx);
        pg8::EpiGU E{ACT, DFF, ss + 2 * MP};
        pg8::gemm_phase<pg8::EpiGU, pg8::StaticOrder, PG8_ALIGN, PG8_SP2>(lds + RING_OFF, g, So, E);
        if (BOTH(6)) GRID_BAR();
    }
    if (IN(7)) {
        pg8::Gemm g{ACT, (const bf16*)(ws + WS_WD2), M, D, DFF}; pg8::StaticOrder So; So.init(M, D, G, bx);
        pg8::EpiRes E{XR, P.out, nullptr, ss + 3 * MP, 0.5f, D};
        pg8::gemm_phase<pg8::EpiRes, pg8::StaticOrder, PG8_ALIGN, PG8_SP2>(lds + RING_OFF, g, So, E);
        if (BOTH(7)) GRID_BAR();
    }
    if (IN(8)) {
        PHASE_TID(); const int gw = vcu * NWAVES + wave, NGW = G * NWAVES; const float* ss4 = ss + 3 * MP;
        f32x4 gv[4];
#pragma unroll
        for (int j = 0; j < 4; ++j) gv[j] = ((const GAS f32x4*)P.fng + lane)[64 * j];
        for (int m = gw; m < M; m += NGW) {
            const float rs = rsqrtf(ss4[m] * (1.f / D) + EPS);
            GAS f32x4* o = (GAS f32x4*)(P.out + (size_t)m * D) + lane;
#pragma unroll
            for (int j = 0; j < 4; ++j) { f32x4 v = o[64 * j]; v = v * gv[j] * rs; o[64 * j] = v; }
        }
    }
#undef IN
#undef BOTH
#undef GRID_BAR
}

#ifndef FUSED_MASK
#define FUSED_MASK 0x1FF
#endif
#ifndef META_NAIVE
#define META_NAIVE 0
#endif
extern "C" void kernel_launch(void* const* d_in, const int* in_sizes, int n_in, void* d_out, int out_size, void* d_ws, size_t ws_size, hipStream_t stream) {
    (void)in_sizes; (void)n_in; (void)out_size;
    static int grid = 0;
    if (grid == 0) {
        if (ws_size < 512 * MiB) { fprintf(stderr, "kernel_launch: workspace %zu < 512 MiB; nothing launched\n", ws_size); grid = -1; return; }
        int dev = 0, cus = 0, per_cu = 0;
        if (hipGetDevice(&dev) != hipSuccess || hipDeviceGetAttribute(&cus, hipDeviceAttributeMultiprocessorCount, dev) != hipSuccess) { grid = -1; return; }
        if (hipFuncSetAttribute((const void*)mega_fwd, hipFuncAttributeMaxDynamicSharedMemorySize, LDS_BYTES) != hipSuccess) { fprintf(stderr, "kernel_launch: hipFuncSetAttribute failed\n"); grid = -1; return; }
        if (hipOccupancyMaxActiveBlocksPerMultiprocessor(&per_cu, (const void*)mega_fwd, NWAVES * 64, LDS_BYTES) != hipSuccess || per_cu < 1) fprintf(stderr, "kernel_launch: occupancy query reports %d\n", per_cu);
        (void)hipGetLastError();
        grid = cus;
    }
    if (grid < 0) return;
    const float* const* in = (const float* const*)d_in;
    unsigned char* ws = (unsigned char*)d_ws; float* out = (float*)d_out;
    float* lamp = (float*)(ws + WS_CTL) + CW_LAM; float2* rope = (float2*)(ws + WS_ROPE);
    float* ss1 = (float*)(ws + WS_SS); float* ss2 = ss1 + MP; float* ss3 = ss2 + MP; float* ss4 = ss3 + MP;
    float* XR = (float*)(ws + WS_XR); bf16_t* XB = (bf16_t*)(ws + WS_XB); bf16_t* ACT = (bf16_t*)(ws + WS_BIG);
    bf16_t* Q = (bf16_t*)(ws + WS_Q); bf16_t* Kb = (bf16_t*)(ws + WS_K); bf16_t* Vb = (bf16_t*)(ws + WS_V); bf16_t* Z = (bf16_t*)(ws + WS_Z); bf16_t* AC = (bf16_t*)(ws + WS_AC);
    (void)hipMemsetAsync(ws + WS_CTL, 0, CTL_ZERO_BYTES, stream);
    Args a{};
    for (int i = 0; i < 23; ++i) a.in[i] = in[i];
    a.out = out; a.ws = ws;
    const int rt_all = (RALL + 63) / 64, rt_m = M / 64;
    int li = 0;
    for (int ph = 0; ph < N_PHASES;) {
        if ((FUSED_MASK >> ph) & 1) {
            int hi = ph + 1;
            if (!META_NAIVE) while (hi < N_PHASES && ((FUSED_MASK >> hi) & 1)) ++hi;
            else while (hi < N_PHASES && ((FUSED_MASK >> hi) & 1) && !(hi >= 2 && hi <= 4)) ++hi;
            a.ph_lo = ph; a.ph_hi = hi; a.li = li++;
            hipLaunchKernelGGL(mega_fwd, dim3(grid), dim3(NWAVES * 64), LDS_BYTES, stream, a);
            if (META_NAIVE) for (int p = ph; p < hi; ++p) {
                if (p == 1) nv::k_gemm_gu<<<dim3(DFF / 64, 1), 256, 0, stream>>>(XB, in[3], in[4], in[2], ss1, ACT, RALL, M);
                if (p == 2) { nv::k_gemm_res<<<dim3(D / 64, 1), 256, 0, stream>>>(ACT, DFF, in[5], in[0], in[1], 0.5f, XR, XB, RALL, M); nv::k_rowss<<<4, 256, 0, stream>>>(XR, ss2, RALL, M); }
                if (p == 3) nv::k_gemm_in<<<dim3(32, 1), 256, 0, stream>>>(XB, in[7], in[6], ss2, rope, Q, Kb, Vb, Z, RALL, M);
            }
            ph = hi; continue;
        }
        switch (ph) {
        case 0: nv::k_prep_rows<<<(RALL + 3) / 4, 256, 0, stream>>>(in[0], in[1], XB, XR, ss1); nv::k_prep_misc<<<(LSEQ * 32 + 255) / 256, 256, 0, stream>>>(rope, lamp, in[8], in[9], in[10], in[11]); break;
        case 1: nv::k_gemm_gu<<<dim3(DFF / 64, rt_all), 256, 0, stream>>>(XB, in[3], in[4], in[2], ss1, ACT, RALL, 0); break;
        case 2: nv::k_gemm_res<<<dim3(D / 64, rt_all), 256, 0, stream>>>(ACT, DFF, in[5], in[0], in[1], 0.5f, XR, XB, RALL, 0); nv::k_rowss<<<(RALL + 3) / 4, 256, 0, stream>>>(XR, ss2, RALL, 0); break;
        case 3: nv::k_gemm_in<<<dim3(32, rt_all), 256, 0, stream>>>(XB, in[7], in[6], ss2, rope, Q, Kb, Vb, Z, RALL, 0); break;
        case 4: nv::k_attn<<<dim3(S / 64, NH, NB), 256, 0, stream>>>(Q, Kb, Vb, in[12], lamp, AC); nv::k_conv<<<M, 256, 0, stream>>>(Z, in[13], in[14], in[15], in[16], AC); break;
        case 5: nv::k_gemm_res<<<dim3(D / 64, rt_m), 256, 0, stream>>>(AC, D, in[17], XR, XR, 1.0f, XR, XB, M, 0); nv::k_rowss<<<M / 4, 256, 0, stream>>>(XR, ss3, M, 0); break;
        case 6: nv::k_gemm_gu<<<dim3(DFF / 64, rt_m), 256, 0, stream>>>(XB, in[19], in[20], in[18], ss3, ACT, M, 0); break;
        case 7: nv::k_gemm_res<<<dim3(D / 64, rt_m), 256, 0, stream>>>(ACT, DFF, in[21], XR, XR, 0.5f, out, nullptr, M, 0); nv::k_rowss<<<M / 4, 256, 0, stream>>>(out, ss4, M, 0); break;
        case 8: nv::k_final<<<M / 4, 256, 0, stream>>>(out, ss4, in[22]); break;
        }
        ++ph;
    }
}
```
